# Optimizing an MI355X kernel written in HIP

```python
import math
import jax, jax.numpy as jnp
from jax import lax
import numpy as np

D_MODEL = 1024
BATCH = 8
SEQ = 2048
DEPTH = 4
DEC_BATCH = 128
DEC_SEQ = 8
PAST_LEN = 16384
PAGE_SIZE = 128

PLE_DIM = 256
BRANCH_W = 256
N_BRANCH = 4
GLA_HEADS = 4
GLA_DK = 32
GLA_DV = 64
GLA_RANK = 16
GLA_TAU = 16.0
GDN_HEADS = 4
GDN_DK = 64
GDN_DV = 64
GDN_CONV = 4
CM_GROUPS = 4
CM_CHUNK = 128
SC_WIDTH = 3
LINEAR_CHUNK = 64
D_FF = ((8 * D_MODEL // 3 + 255) // 256) * 256
EPS = 1e-6
IN_SIZES = (GLA_HEADS * GLA_DK, GLA_HEADS * GLA_DK, GLA_HEADS * GLA_DV, GLA_HEADS * GLA_DV, GLA_RANK,
            GDN_HEADS * GDN_DK, GDN_HEADS * GDN_DK, GDN_HEADS * GDN_DV, GDN_HEADS * GDN_DV, GDN_HEADS, GDN_HEADS,
            BRANCH_W, BRANCH_W,
            BRANCH_W, BRANCH_W, BRANCH_W)
IN_WIDTH = sum(IN_SIZES)

kernel_name = 'hybrid_gla_gdn_chunkmlp_shortconv_step'


def _rmsnorm(x, g):
    xf = x.astype(jnp.float32)
    y = xf * lax.rsqrt(jnp.mean(xf * xf, axis=-1, keepdims=True) + EPS)
    return (y * g.astype(jnp.float32)).astype(x.dtype)


def _layernorm(x, g, b):
    xf = x.astype(jnp.float32)
    mu = jnp.mean(xf, axis=-1, keepdims=True)
    var = jnp.mean(jnp.square(xf - mu), axis=-1, keepdims=True)
    y = (xf - mu) * lax.rsqrt(var + EPS)
    return (y * g.astype(jnp.float32) + b.astype(jnp.float32)).astype(x.dtype)


def _l2norm(x):
    return x * lax.rsqrt(jnp.sum(x * x, axis=-1, keepdims=True) + EPS)


def _causal_dwconv(x, buf, w):
    width = w.shape[0]
    T = x.shape[1]
    xp = jnp.concatenate([buf.astype(x.dtype), x], axis=1)
    y = w[0] * xp[:, 0:T]
    for j in range(1, width):
        y = y + w[j] * xp[:, j:j + T]
    return y, xp[:, xp.shape[1] - (width - 1):]


def _split_cols(proj):
    idx = []
    acc = 0
    for s in IN_SIZES[:-1]:
        acc += s
        idx.append(acc)
    return jnp.split(proj, idx, axis=-1)


def _chunk_len(T):
    return math.gcd(T, LINEAR_CHUNK)


def _gla_chunked(q, k, v, log_a, S0):
    B, T, H, K = q.shape
    L = _chunk_len(T)
    N = T // L
    q, k, v, log_a = [a.reshape(B, N, L, H, a.shape[-1]) for a in (q, k, v, log_a)]
    b = jnp.cumsum(log_a, axis=2)
    b_last = b[:, :, -1:]
    q_d = q * jnp.exp(b)
    k_d = k * jnp.exp(-b)
    k_e = k * jnp.exp(b_last - b)
    mask = jnp.tril(jnp.ones((L, L), dtype=bool))
    A = jnp.where(mask, jnp.einsum('bnlhk,bnmhk->bnhlm', q_d, k_d), 0.0)
    o_intra = jnp.einsum('bnhlm,bnmhv->bnlhv', A, v)
    dec = jnp.exp(b[:, :, -1])
    dS = jnp.einsum('bnlhk,bnlhv->bnhkv', k_e, v)

    def step(S, inp):
        qd, dc, ds = inp
        o = jnp.einsum('blhk,bhkv->blhv', qd, S)
        return dc[..., None] * S + ds, o

    S_fin, o_inter = lax.scan(step, S0, (jnp.moveaxis(q_d, 1, 0), jnp.moveaxis(dec, 1, 0), jnp.moveaxis(dS, 1, 0)))
    o = o_intra + jnp.moveaxis(o_inter, 0, 1)
    return o.reshape(B, T, H, v.shape[-1]), S_fin


def _gdn_chunked(q, k, v, g, beta, S0):
    B, T, H, K = q.shape
    V = v.shape[-1]
    L = _chunk_len(T)
    N = T // L
    qh = jnp.transpose(q.reshape(B, N, L, H, K), (0, 1, 3, 2, 4))
    kh = jnp.transpose(k.reshape(B, N, L, H, K), (0, 1, 3, 2, 4))
    vh = jnp.transpose(v.reshape(B, N, L, H, V), (0, 1, 3, 2, 4))
    Gh = jnp.cumsum(jnp.moveaxis(g.reshape(B, N, L, H), -1, 2), axis=-1)
    bh = jnp.moveaxis(beta.reshape(B, N, L, H), -1, 2)
    incl = jnp.tril(jnp.ones((L, L), dtype=bool))
    strict = jnp.tril(jnp.ones((L, L), dtype=bool), -1)
    diff = Gh[..., :, None] - Gh[..., None, :]
    decay = jnp.where(incl, jnp.exp(jnp.where(incl, diff, 0.0)), 0.0)
    kk = jnp.einsum('bnhlk,bnhmk->bnhlm', kh, kh)
    M = jnp.eye(L, dtype=q.dtype) + jnp.where(strict, bh[..., :, None] * decay * kk, 0.0)
    U = lax.linalg.triangular_solve(M, bh[..., None] * vh, left_side=True, lower=True, unit_diagonal=True)
    W = lax.linalg.triangular_solve(M, (bh * jnp.exp(Gh))[..., None] * kh, left_side=True, lower=True, unit_diagonal=True)
    qk = jnp.einsum('bnhlk,bnhmk->bnhlm', qh, kh) * decay
    q_g = qh * jnp.exp(Gh)[..., None]
    k_end = kh * jnp.exp(Gh[..., -1:] - Gh)[..., None]
    dec_end = jnp.exp(Gh[..., -1])

    def step(S, inp):
        Wn, Un, qkn, qgn, ken, dn = inp
        u = Un - jnp.einsum('bhlk,bhkv->bhlv', Wn, S)
        o = jnp.einsum('bhlk,bhkv->bhlv', qgn, S) + jnp.einsum('bhlm,bhmv->bhlv', qkn, u)
        S = dn[..., None, None] * S + jnp.einsum('bhlk,bhlv->bhkv', ken, u)
        return S, o

    mv = lambda a: jnp.moveaxis(a, 1, 0)
    S_fin, o = lax.scan(step, S0, (mv(W), mv(U), mv(qk), mv(q_g), mv(k_end), mv(dec_end)))
    o = jnp.transpose(o, (1, 0, 3, 2, 4)).reshape(B, T, H, V)
    return o, S_fin


def _chunk_mlp(u, v, ln_g, ln_b, ws, bs):
    B, T, C = v.shape
    vn = _layernorm(v, ln_g, ln_b)
    pad = (-T) % CM_CHUNK
    N = (T + pad) // CM_CHUNK
    vp = jnp.pad(vn, ((0, 0), (0, pad), (0, 0))).reshape(B, N, CM_CHUNK, CM_GROUPS, C // CM_GROUPS)
    wm = jnp.where(jnp.tril(jnp.ones((CM_CHUNK, CM_CHUNK), dtype=bool)), ws, 0.0)
    s = jnp.einsum('gts,bnsgc->bntgc', wm, vp) + jnp.transpose(bs)[:, :, None]
    s = s.reshape(B, N * CM_CHUNK, C)[:, :T]
    return u * s, vn


def _layer(h, pe, s_gla, s_gdn, b_gdn, b_sc, lp):
    f32 = jnp.float32
    B, T, _ = h.shape
    xn = _rmsnorm(h, lp['norm_mix'])
    (g_q, g_k, g_v, g_r, g_a, d_q, d_k, d_v, d_z, d_a, d_b,
     c_u, c_v, s_h, s_b, s_c) = _split_cols(xn @ lp['w_in'])
    q = g_q.reshape(B, T, GLA_HEADS, GLA_DK).astype(f32) * (GLA_DK ** -0.5)
    k = g_k.reshape(B, T, GLA_HEADS, GLA_DK).astype(f32)
    v = g_v.reshape(B, T, GLA_HEADS, GLA_DV).astype(f32)
    log_a = jax.nn.log_sigmoid((g_a @ lp['gla_wa2'] + lp['gla_ba']).astype(f32)).reshape(B, T, GLA_HEADS, GLA_DK) / GLA_TAU
    o, s_gla_new = _gla_chunked(q, k, v, log_a, s_gla.astype(f32))
    o_gla = (_rmsnorm(o, lp['gla_norm']).reshape(B, T, BRANCH_W) * jax.nn.silu(g_r.astype(f32))).astype(h.dtype)
    qkv, b_gdn_new = _causal_dwconv(jnp.concatenate([d_q, d_k, d_v], axis=-1), b_gdn, lp['gdn_conv_w'])
    qkv = jax.nn.silu(qkv.astype(f32))
    cq, ck, cv = jnp.split(qkv, [GDN_HEADS * GDN_DK, 2 * GDN_HEADS * GDN_DK], axis=-1)
    q = _l2norm(cq.reshape(B, T, GDN_HEADS, GDN_DK)) * (GDN_DK ** -0.5)
    k = _l2norm(ck.reshape(B, T, GDN_HEADS, GDN_DK))
    v = cv.reshape(B, T, GDN_HEADS, GDN_DV)
    g = -jnp.exp(lp['gdn_a_log'].astype(f32)) * jax.nn.softplus(d_a.astype(f32) + lp['gdn_dt_bias'].astype(f32))
    beta = jax.nn.sigmoid(d_b.astype(f32))
    o, s_gdn_new = _gdn_chunked(q, k, v, g, beta, s_gdn.astype(f32))
    o_gdn = (_rmsnorm(o, lp['gdn_norm']).reshape(B, T, BRANCH_W) * jax.nn.silu(d_z.astype(f32))).astype(h.dtype)
    o_cm, vn = _chunk_mlp(jax.nn.gelu(c_u), jax.nn.gelu(c_v), lp['cm_ln_g'], lp['cm_ln_b'], lp['cm_ws'], lp['cm_bs'])
    y_sc, b_sc_new = _causal_dwconv(s_c * s_h, b_sc, lp['sc_conv_w'])
    o_sc = s_b * y_sc
    branches = jnp.stack([o_gla, o_gdn, o_cm.astype(h.dtype), o_sc], axis=2)
    gates = jax.nn.sigmoid(xn @ lp['w_gate']).reshape(B, T, N_BRANCH, D_MODEL)
    merged = jnp.sum(jnp.einsum('btgc,gcd->btgd', branches, lp['w_branch']) * gates, axis=2)
    h = h + merged @ lp['w_o']
    xf = _rmsnorm(h, lp['norm_ffn'])
    h = h + (jax.nn.silu(xf @ lp['w_ffn_gate']) * (xf @ lp['w_ffn_up'])) @ lp['w_ffn_down']
    pg = jax.nn.sigmoid(_rmsnorm(h, lp['norm_ple']) @ lp['w_ple_gate'])
    h = h + pg * (pe @ lp['w_ple'])
    return h, s_gla_new.astype(h.dtype), s_gdn_new.astype(h.dtype), b_gdn_new, b_sc_new, vn


def setup_inputs(seed: int = 0) -> dict:
    key = jax.random.key(seed)
    ks = jax.random.split(key, 40)
    f32 = jnp.float32

    def nrm(k, shape, scale):
        return jax.random.normal(k, shape, f32) * scale

    def gain(k, shape):
        return 1.0 + 0.02 * jax.random.normal(k, shape, f32)

    dt = jnp.exp(jax.random.uniform(ks[20], (DEPTH, GDN_HEADS), f32, math.log(0.001), math.log(0.1)))
    return {
        'x_prompt': nrm(ks[0], (BATCH, SEQ, D_MODEL), 1.0),
        'x_sample': nrm(ks[1], (DEC_BATCH, DEC_SEQ, D_MODEL), 1.0),
        'state_gla': nrm(ks[2], (DEPTH, DEC_BATCH, GLA_HEADS, GLA_DK, GLA_DV), 0.5),
        'state_gdn': nrm(ks[3], (DEPTH, DEC_BATCH, GDN_HEADS, GDN_DK, GDN_DV), 0.1),
        'state_gdn_conv': nrm(ks[4], (DEPTH, DEC_BATCH, GDN_CONV - 1, 2 * GDN_HEADS * GDN_DK + GDN_HEADS * GDN_DV), 1.0),
        'state_sconv': nrm(ks[5], (DEPTH, DEC_BATCH, SC_WIDTH - 1, BRANCH_W), 1.0),
        'p_prompt': nrm(ks[6], (DEPTH, BATCH, SEQ, PLE_DIM), 1.0),
        'p_sample': nrm(ks[7], (DEPTH, DEC_BATCH, DEC_SEQ, PLE_DIM), 1.0),
        'norm_mix': gain(ks[8], (DEPTH, D_MODEL)),
        'w_in': nrm(ks[9], (DEPTH, D_MODEL, IN_WIDTH), D_MODEL ** -0.5),
        'gla_wa2': nrm(ks[10], (DEPTH, GLA_RANK, GLA_HEADS * GLA_DK), GLA_RANK ** -0.5),
        'gla_ba': nrm(ks[11], (DEPTH, GLA_HEADS * GLA_DK), 0.1),
        'gla_norm': gain(ks[12], (DEPTH, GLA_DV)),
        'gdn_conv_w': nrm(ks[13], (DEPTH, GDN_CONV, 2 * GDN_HEADS * GDN_DK + GDN_HEADS * GDN_DV), GDN_CONV ** -0.5),
        'gdn_a_log': jnp.log(jax.random.uniform(ks[14], (DEPTH, GDN_HEADS), f32, 1.0, 16.0)),
        'gdn_dt_bias': dt + jnp.log(-jnp.expm1(-dt)),
        'gdn_norm': gain(ks[15], (DEPTH, GDN_DV)),
        'cm_ln_g': gain(ks[16], (DEPTH, BRANCH_W)),
        'cm_ln_b': nrm(ks[17], (DEPTH, BRANCH_W), 0.02),
        'cm_ws': nrm(ks[18], (DEPTH, CM_GROUPS, CM_CHUNK, CM_CHUNK), CM_CHUNK ** -0.5),
        'cm_bs': 1.0 + nrm(ks[19], (DEPTH, CM_GROUPS, CM_CHUNK), 0.1),
        'sc_conv_w': nrm(ks[21], (DEPTH, SC_WIDTH, BRANCH_W), SC_WIDTH ** -0.5),
        'w_gate': nrm(ks[22], (DEPTH, D_MODEL, N_BRANCH * D_MODEL), D_MODEL ** -0.5),
        'w_branch': nrm(ks[23], (DEPTH, N_BRANCH, BRANCH_W, D_MODEL), BRANCH_W ** -0.5),
        'w_o': nrm(ks[24], (DEPTH, D_MODEL, D_MODEL), D_MODEL ** -0.5),
        'norm_ffn': gain(ks[25], (DEPTH, D_MODEL)),
        'w_ffn_gate': nrm(ks[26], (DEPTH, D_MODEL, D_FF), D_MODEL ** -0.5),
        'w_ffn_up': nrm(ks[27], (DEPTH, D_MODEL, D_FF), D_MODEL ** -0.5),
        'w_ffn_down': nrm(ks[28], (DEPTH, D_FF, D_MODEL), D_FF ** -0.5),
        'norm_ple': gain(ks[29], (DEPTH, D_MODEL)),
        'w_ple_gate': nrm(ks[30], (DEPTH, D_MODEL, D_MODEL), D_MODEL ** -0.5),
        'w_ple': nrm(ks[31], (DEPTH, PLE_DIM, D_MODEL), PLE_DIM ** -0.5),
        'norm_final': gain(ks[32], (D_MODEL,)),
    }


def reference(x_prompt, x_sample, state_gla, state_gdn, state_gdn_conv, state_sconv, p_prompt, p_sample,
              norm_mix, w_in, gla_wa2, gla_ba, gla_norm, gdn_conv_w, gdn_a_log, gdn_dt_bias, gdn_norm,
              cm_ln_g, cm_ln_b, cm_ws, cm_bs, sc_conv_w, w_gate, w_branch, w_o,
              norm_ffn, w_ffn_gate, w_ffn_up, w_ffn_down, norm_ple, w_ple_gate, w_ple, norm_final):
    dt = x_prompt.dtype
    bp = x_prompt.shape[0]
    z_gla = jnp.zeros((bp, GLA_HEADS, GLA_DK, GLA_DV), dt)
    z_gdn = jnp.zeros((bp, GDN_HEADS, GDN_DK, GDN_DV), dt)
    z_gdn_buf = jnp.zeros((bp, GDN_CONV - 1, state_gdn_conv.shape[-1]), dt)
    z_sc_buf = jnp.zeros((bp, SC_WIDTH - 1, BRANCH_W), dt)
    hp, hs = x_prompt, x_sample
    gla_p, gla_s, gdn_p, gdn_s, gc_p, gc_s, sc_p, sc_s, cv_s = [], [], [], [], [], [], [], [], []
    for i in range(DEPTH):
        lp = {'norm_mix': norm_mix[i], 'w_in': w_in[i], 'gla_wa2': gla_wa2[i], 'gla_ba': gla_ba[i],
              'gla_norm': gla_norm[i], 'gdn_conv_w': gdn_conv_w[i], 'gdn_a_log': gdn_a_log[i],
              'gdn_dt_bias': gdn_dt_bias[i], 'gdn_norm': gdn_norm[i], 'cm_ln_g': cm_ln_g[i], 'cm_ln_b': cm_ln_b[i],
              'cm_ws': cm_ws[i], 'cm_bs': cm_bs[i], 'sc_conv_w': sc_conv_w[i], 'w_gate': w_gate[i],
              'w_branch': w_branch[i], 'w_o': w_o[i], 'norm_ffn': norm_ffn[i], 'w_ffn_gate': w_ffn_gate[i],
              'w_ffn_up': w_ffn_up[i], 'w_ffn_down': w_ffn_down[i], 'norm_ple': norm_ple[i],
              'w_ple_gate': w_ple_gate[i], 'w_ple': w_ple[i]}
        hp, a, b, c, d, _ = _layer(hp, p_prompt[i], z_gla, z_gdn, z_gdn_buf, z_sc_buf, lp)
        gla_p.append(a); gdn_p.append(b); gc_p.append(c); sc_p.append(d)
        hs, a, b, c, d, e = _layer(hs, p_sample[i], state_gla[i], state_gdn[i], state_gdn_conv[i], state_sconv[i], lp)
        gla_s.append(a); gdn_s.append(b); gc_s.append(c); sc_s.append(d); cv_s.append(e)
    y_prompt = _rmsnorm(hp, norm_final)
    y_sample = _rmsnorm(hs, norm_final)
    return (y_prompt, y_sample, jnp.stack(gla_p), jnp.stack(gla_s), jnp.stack(gdn_p), jnp.stack(gdn_s),
            jnp.stack(gc_p), jnp.stack(gc_s), jnp.stack(sc_p), jnp.stack(sc_s), jnp.stack(cv_s))
```

```cpp
#include <hip/hip_runtime.h>
#include <hip/hip_cooperative_groups.h>
#include <cstdio>
namespace cg = cooperative_groups;
namespace pg8 {
#define PG8_LAS __attribute__((address_space(3)))
typedef unsigned short bf16_t;
typedef short bf16x8 __attribute__((ext_vector_type(8)));
typedef float f32x4 __attribute__((ext_vector_type(4)));
typedef unsigned u32x4 __attribute__((ext_vector_type(4)));
constexpr int BM = 256, BK = 64, HALF = 128, HTB = HALF * BK * 2  , STAGE_BYTES = 8 * HTB, NXCD = 8, WGM = 8;

__host__ __device__ __forceinline__ int lds_byte(int r, int c) { const int st = (r >> 4) * 2 + (c >> 5), rr = r & 15, cc = c & 31, ob = rr * 64 + cc * 2; return st * 1024 + (ob ^ (((ob >> 9) & 1) << 5)); }
__host__ __device__ __forceinline__ void stage_rc(int b, int& R, int& C) { const int st = b / 1024, sb = b % 1024, swz = sb ^ (((sb >> 9) & 1) << 5); R = (st >> 1) * 16 + swz / 64; C = (st & 1) * 32 + (swz % 64) / 2; }
__host__ __device__ __forceinline__ int perm32(int rho) { const int n = rho >> 4, i = rho & 15; return 8 * (i >> 2) + 4 * n + (i & 3); }

struct Unit { int pm, pn; };
struct Gemm { const bf16_t* A; const bf16_t* Bt; int M, N, K; };

struct StaticOrder {
    int nM, nN, nwg, G, c;
    __host__ __device__ void init(int M, int N, int G_, int c_) { nM = M / BM; nN = N / BM; nwg = nM * nN; G = G_; c = c_; }
    __host__ __device__ bool next(int i, Unit& u) const {
        const long L = (long)i * G + c; if (L >= nwg) return false;
        int wgid = (int)L; { const int q = nwg / NXCD, r = nwg % NXCD, xcd = wgid % NXCD, off = wgid / NXCD; wgid = (xcd < r ? xcd * (q + 1) : r * (q + 1) + (xcd - r) * q) + off; }
        const int nig = WGM * nN, gid = wgid / nig, fm = gid * WGM, gsz = (nM - fm) < WGM ? (nM - fm) : WGM;
        u.pm = fm + ((wgid % nig) % gsz); u.pn = (wgid % nig) / gsz; return true;
    }
    __device__ __forceinline__ void a_ready(const Unit&) const {}
    __device__ __forceinline__ void done(const Unit&) const {}
};
__device__ __forceinline__ unsigned cvt_pk_bf16(float lo, float hi) { unsigned r; asm volatile("v_cvt_pk_bf16_f32 %0, %1, %2" : "=v"(r) : "v"(lo), "v"(hi)); return r; }
template <class Epi, class Sched, bool STAMP = false>
__device__ __forceinline__ void gemm_phase(int WV, PG8_LAS unsigned char* lds, const Gemm g, const Sched& S, const Epi& E, unsigned long long* stamps) {
    int lid_; asm volatile("v_mbcnt_lo_u32_b32 %0, -1, 0\n\tv_mbcnt_hi_u32_b32 %0, -1, %0" : "=v"(lid_)); const int tid = WV * 64 + lid_, wid = WV, lane = tid & 63, wr = wid >> 2, wc = wid & 3, fr = lane & 15, fq = lane >> 4;
    const int K = g.K, nt = K / BK;
    int ts_lo = 0, ts_hi = 0, nts = 0; const unsigned long long rt_entry = STAMP ? (unsigned long long)wall_clock64() : 0ull;
#define PG8_STAMP() do { if (STAMP && wid == 0 && nts < 64) { const unsigned long long _c = (unsigned long long)clock64(); \
        ts_lo = (lane == nts) ? (int)(unsigned)_c : ts_lo; ts_hi = (lane == nts) ? (int)(unsigned)(_c >> 32) : ts_hi; ++nts; } } while (0)
    PG8_STAMP();
    unsigned voffA[2], voffB[2];
#pragma unroll
    for (int i = 0; i < 2; ++i) { int R, C; stage_rc(tid * 16 + i * 8192, R, C); const int Rb = Epi::PERM ? ((R & ~31) + perm32(R & 31)) : R;
        voffA[i] = (unsigned)(R * K + C) * 2u; voffB[i] = (unsigned)(Rb * K + C) * 2u; }
    const size_t kstep = (size_t)(BK * 2);
    const size_t hstep = (size_t)HALF * K * 2;
    const size_t tstep = 2 * hstep;
    const unsigned ldsw = (unsigned)wid * 1024u;
    const int aoff = lds_byte(wr * 64 + fr, fq * 8), boff = lds_byte(wc * 32 + fr, fq * 8);
#define PG8_SA(b, h) (((b) * 2 + (h)) * HTB)
#define PG8_SB(b, h) ((4 + (b) * 2 + (h)) * HTB)
#define PG8_STAGE(bufoff, gbase, voff) do { _Pragma("unroll") for (int _i = 0; _i < 2; ++_i) \
        __builtin_amdgcn_global_load_lds((const unsigned*)((const char*)(gbase) + (voff)[_i]), (PG8_LAS unsigned*)(lds + (bufoff) + ldsw + _i * 8192), 16, 0, 0); } while (0)
#define PG8_LDA(dst, b, h) do { _Pragma("unroll") for (int m = 0; m < 4; ++m) _Pragma("unroll") for (int k = 0; k < 2; ++k) dst[m][k] = *(const PG8_LAS bf16x8*)(lds + PG8_SA(b, h) + aoff + m * 2048 + k * 1024); } while (0)
#define PG8_LDB(dst, b, h) do { _Pragma("unroll") for (int n = 0; n < 2; ++n) _Pragma("unroll") for (int k = 0; k < 2; ++k) dst[n][k] = *(const PG8_LAS bf16x8*)(lds + PG8_SB(b, h) + boff + n * 2048 + k * 1024); } while (0)
#define PG8_MMA(ai, bj, At, Bt) do { __builtin_amdgcn_s_setprio(1); _Pragma("unroll") for (int m = 0; m < 4; ++m) _Pragma("unroll") for (int n = 0; n < 2; ++n) _Pragma("unroll") for (int k = 0; k < 2; ++k) \
        acc[ai][bj][m][n] = __builtin_amdgcn_mfma_f32_16x16x32_bf16(Bt[n][k], At[m][k], acc[ai][bj][m][n], 0, 0, 0); __builtin_amdgcn_s_setprio(0); } while (0)
#define PG8_WAIT_V(n) asm volatile("s_waitcnt vmcnt(" #n ")" ::: "memory")
#define PG8_WAIT_L(n) asm volatile("s_waitcnt lgkmcnt(" #n ")" ::: "memory")
#define PG8_BAR __builtin_amdgcn_s_barrier()
#define PG8_SCHED __builtin_amdgcn_sched_barrier(0)
    Unit cur, nxt; int ui = 0;
    if (!S.next(0, cur)) return;
    f32x4 acc[2][2][4][2];
#pragma unroll
    for (int a = 0; a < 2; ++a)
#pragma unroll
        for (int b = 0; b < 2; ++b)
#pragma unroll
            for (int m = 0; m < 4; ++m)
#pragma unroll
                for (int n = 0; n < 2; ++n) acc[a][b][m][n] = (f32x4){0.f, 0.f, 0.f, 0.f};
    bf16x8 At[4][2], B0[2][2], B1[2][2];
    const char* cA = (const char*)g.A + (size_t)cur.pm * tstep; const char* cB = (const char*)g.Bt + (size_t)cur.pn * tstep;
    S.a_ready(cur);
    PG8_STAGE(PG8_SB(0, 0), cB, voffB); PG8_STAGE(PG8_SA(0, 0), cA, voffA); PG8_STAGE(PG8_SB(0, 1), cB + hstep, voffB); PG8_STAGE(PG8_SA(0, 1), cA + hstep, voffA);
    if (wr == 1) PG8_BAR;
    PG8_WAIT_V(4); PG8_BAR;
    PG8_STAGE(PG8_SB(1, 0), cB + kstep, voffB); PG8_STAGE(PG8_SA(1, 0), cA + kstep, voffA); PG8_STAGE(PG8_SB(1, 1), cB + hstep + kstep, voffB);
    PG8_WAIT_V(6); PG8_BAR;
    PG8_STAMP();
    for (;;) {
        const bool has_next = S.next(ui + 1, nxt);
        const char* nA = has_next ? (const char*)g.A + (size_t)nxt.pm * tstep : cA; const char* nB = has_next ? (const char*)g.Bt + (size_t)nxt.pn * tstep : cB;
        for (int t = 0; t < nt; t += 2) {
            const bool last = (t == nt - 2);
            const char* a1 = cA + (size_t)(t + 1) * kstep;
            const char* a2 = last ? nA : cA + (size_t)(t + 2) * kstep; const char* b2 = last ? nB : cB + (size_t)(t + 2) * kstep;
            const char* a3 = a2 + kstep; const char* b3 = b2 + kstep;
            if (last && has_next) S.a_ready(nxt);
            PG8_LDB(B0, 0, 0); PG8_SCHED; PG8_LDA(At, 0, 0); PG8_STAGE(PG8_SA(1, 1), a1 + hstep, voffA);
            PG8_WAIT_L(8); PG8_BAR; PG8_WAIT_L(0); PG8_MMA(0, 0, At, B0); PG8_BAR; PG8_SCHED;
            PG8_LDB(B1, 0, 1); PG8_STAGE(PG8_SB(0, 0), b2, voffB);
            PG8_BAR; PG8_WAIT_L(0); PG8_MMA(0, 1, At, B1); PG8_BAR;
            PG8_LDA(At, 0, 1); PG8_STAGE(PG8_SA(0, 0), a2, voffA);
            PG8_BAR; PG8_WAIT_L(0); PG8_MMA(1, 0, At, B0); PG8_BAR; PG8_SCHED;
            PG8_STAGE(PG8_SB(0, 1), b2 + hstep, voffB);
            PG8_WAIT_V(6); PG8_BAR; PG8_MMA(1, 1, At, B1); PG8_BAR;
            PG8_LDB(B0, 1, 0); PG8_SCHED; PG8_LDA(At, 1, 0); PG8_STAGE(PG8_SA(0, 1), a2 + hstep, voffA);
            PG8_WAIT_L(8); PG8_BAR; PG8_WAIT_L(0); PG8_MMA(0, 0, At, B0); PG8_BAR; PG8_SCHED;
            PG8_LDB(B1, 1, 1); PG8_STAGE(PG8_SB(1, 0), b3, voffB);
            PG8_BAR; PG8_WAIT_L(0); PG8_MMA(0, 1, At, B1); PG8_BAR;
            PG8_LDA(At, 1, 1); PG8_STAGE(PG8_SA(1, 0), a3, voffA);
            PG8_BAR; PG8_WAIT_L(0); PG8_MMA(1, 0, At, B0); PG8_BAR; PG8_SCHED;
            PG8_STAGE(PG8_SB(1, 1), b3 + hstep, voffB);
            PG8_WAIT_V(6); PG8_BAR; PG8_MMA(1, 1, At, B1); PG8_BAR;
        }
        PG8_STAMP();
        if constexpr (!Epi::AFTER_DRAIN) { E(acc, cur, wr, wc, fr, fq); S.done(cur); }
        PG8_STAMP();
        if (!has_next) break;
#pragma unroll
        for (int a = 0; a < 2; ++a)
#pragma unroll
            for (int b = 0; b < 2; ++b)
#pragma unroll
                for (int m = 0; m < 4; ++m)
#pragma unroll
                    for (int n = 0; n < 2; ++n) acc[a][b][m][n] = (f32x4){0.f, 0.f, 0.f, 0.f};
        cur = nxt; cA = nA; cB = nB; ++ui;
    }
    PG8_WAIT_V(0);
    if (wr == 0) PG8_BAR;
    PG8_BAR;
    if constexpr (Epi::AFTER_DRAIN) { E.fused(acc, cur, wr, wc, fr, fq, lds, wid, lane); S.done(cur); }
    PG8_STAMP();
    if (STAMP && wid == 0) { stamps[lane] = lane < nts ? (((unsigned long long)(unsigned)ts_hi << 32) | (unsigned)ts_lo) : 0ull;
        if (lane == 62) stamps[62] = rt_entry; if (lane == 63) stamps[63] = (unsigned long long)wall_clock64(); }
#undef PG8_STAMP
#undef PG8_SA
#undef PG8_SB
#undef PG8_STAGE
#undef PG8_LDA
#undef PG8_LDB
#undef PG8_MMA
#undef PG8_WAIT_V
#undef PG8_WAIT_L
#undef PG8_BAR
#undef PG8_SCHED
}
}

using pg8::bf16_t; using pg8::f32x4; using pg8::Unit;
constexpr int MT = 17408, MPR = 16384, NINP = 3328, DFF = 2816;
constexpr float EPSV = 1e-6f;
constexpr int C_GQ = 0, C_GK = 128, C_GV = 256, C_GR = 512, C_GA = 768, C_DQ = 784, C_DZ = 1552, C_DA = 1808, C_DB = 1812, C_CU = 1816, C_CV = 2072, C_SH = 2328, C_SB = 2584, C_SC = 2840;
constexpr size_t O_IN = 0, O_GATE = O_IN + (size_t)3328 * 1024, O_BR = O_GATE + (size_t)4096 * 1024, O_O = O_BR + (size_t)1024 * 1024, O_GU = O_O + (size_t)1024 * 1024,
                 O_DN = O_GU + (size_t)5632 * 1024, O_PG = O_DN + (size_t)1024 * 2816, O_PLE = O_PG + (size_t)1024 * 1024, W_ELEMS = O_PLE + (size_t)1024 * 256;
constexpr size_t WS_W0 = 0, WS_W1 = WS_W0 + W_ELEMS * 2, WS_PROJ = WS_W1 + W_ELEMS * 2, WS_GATES = WS_PROJ + (size_t)MT * NINP * 2, WS_HB = WS_GATES + (size_t)MT * 4096 * 2,
                 WS_HB2 = WS_HB + (size_t)MT * 1024 * 2, WS_BR = WS_HB2 + (size_t)MT * 1024 * 2, WS_PB = WS_BR + (size_t)MT * 1024 * 2, WS_SS = WS_PB + (size_t)MT * 256 * 2, WS_END = WS_SS + (size_t)13 * MT * 16 * 4;
constexpr size_t PR_MER = 0, PR_MERGED = (size_t)MT * 1024 * 4;
constexpr size_t SC_GT = 0, SC_GR = SC_GT + (size_t)1024 * 4096, SC_GQ = SC_GR + (size_t)1024 * 4096, SC_GO = SC_GQ + (size_t)1024 * 4096, SC_GS = SC_GO + (size_t)1024 * 4096,
                 SC_ADS = SC_GS + (size_t)1024 * 4096, SC_AS = SC_ADS + (size_t)1024 * 2048, SC_ADEC = SC_AS + (size_t)1024 * 2048;
constexpr size_t OUT_GLAP = 17825792, OUT_GLAS = 18087936, OUT_GDNP = 22282240, OUT_GDNS = 22806528, OUT_GCP = 31195136, OUT_GCS = 31268864, OUT_SCP = 32448512, OUT_SCS = 32464896, OUT_CVS = 32727040;

struct KP { const float* in[33]; float* out; unsigned char* ws; };

__device__ __forceinline__ float bf2f(bf16_t b) { return __uint_as_float(((unsigned)b) << 16); }
__device__ __forceinline__ unsigned pk2(float lo, float hi) { return pg8::cvt_pk_bf16(lo, hi); }
__device__ __forceinline__ void unpack4(uint2 v, float* o) { o[0] = __uint_as_float(v.x << 16); o[1] = __uint_as_float(v.x & 0xffff0000u); o[2] = __uint_as_float(v.y << 16); o[3] = __uint_as_float(v.y & 0xffff0000u); }
__device__ __forceinline__ float sigm(float x) { return 1.f / (1.f + __expf(-x)); }
__device__ __forceinline__ float siluf_(float x) { return x / (1.f + __expf(-x)); }
__device__ __forceinline__ float softplusf_(float x) { return x > 20.f ? x : log1pf(__expf(x)); }
__device__ __forceinline__ float logsigm(float x) { return fminf(x, 0.f) - log1pf(__expf(-fabsf(x))); }
__device__ __forceinline__ float geluf_(float x) { const float y = 0.7978845608f * (x + 0.044715f * x * x * x); const float t = 1.f - 2.f / (1.f + __expf(2.f * y)); return 0.5f * x * (1.f + t); }
template <int M> __device__ __forceinline__ float swz(float v) { return __int_as_float(__builtin_amdgcn_ds_swizzle(__float_as_int(v), (M << 10) | 0x1f)); }
__device__ __forceinline__ float bperm(int srclane, float v) { return __int_as_float(__builtin_amdgcn_ds_bpermute(srclane << 2, __float_as_int(v))); }
__device__ __forceinline__ float wave_sum(float v) {
    v += swz<1>(v); v += swz<2>(v); v += swz<4>(v); v += swz<8>(v); v += swz<16>(v);
    return __int_as_float(__builtin_amdgcn_readlane(__float_as_int(v), 0)) + __int_as_float(__builtin_amdgcn_readlane(__float_as_int(v), 32));
}
__device__ __forceinline__ int otid(int WV) { int t; asm volatile("v_mbcnt_lo_u32_b32 %0, -1, 0\n\tv_mbcnt_hi_u32_b32 %0, -1, %0" : "=v"(t)); return WV * 64 + t; }
__device__ __forceinline__ int obid() { int t = blockIdx.x; asm volatile("" : "+s"(t)); return t; }
__device__ __forceinline__ float rdl(float v, int l) { return __int_as_float(__builtin_amdgcn_readlane(__float_as_int(v), l)); }

__device__ __forceinline__ float row_rstd(const float* ssp, int r) { const f32x4* q = (const f32x4*)(ssp + (size_t)r * 16); const f32x4 a = q[0], b = q[1], c = q[2], d = q[3];
    const float s = (((a[0] + a[1]) + (a[2] + a[3])) + ((b[0] + b[1]) + (b[2] + b[3]))) + (((c[0] + c[1]) + (c[2] + c[3])) + ((d[0] + d[1]) + (d[2] + d[3]))); return rsqrtf(s * (1.f / 1024.f) + EPSV); }
#define EPI_ROWS _Pragma("unroll") for (int ai = 0; ai < 2; ++ai) _Pragma("unroll") for (int m = 0; m < 4; ++m)
#define EPI_COLS _Pragma("unroll") for (int bj = 0; bj < 2; ++bj) _Pragma("unroll") for (int n = 0; n < 2; ++n)
#define EPI_R (u.pm * 256 + ai * 128 + wr * 64 + m * 16 + fr)
#define EPI_C (u.pn * 256 + bj * 128 + wc * 32 + n * 16 + 4 * fq)
struct EpiProj {
    static constexpr bool PERM = false, AFTER_DRAIN = false;
    bf16_t* O; int ldo; const float* ss; int act;
    __device__ __forceinline__ void operator()(const f32x4 (&acc)[2][2][4][2], const Unit& u, int wr, int wc, int fr, int fq) const {
        EPI_ROWS { const int r = EPI_R; const float rstd = row_rstd(ss, r);
            EPI_COLS { const int c = EPI_C; f32x4 v = acc[ai][bj][m][n] * rstd;
                if (act) { v[0] = sigm(v[0]); v[1] = sigm(v[1]); v[2] = sigm(v[2]); v[3] = sigm(v[3]); }
                uint2 w; w.x = pk2(v[0], v[1]); w.y = pk2(v[2], v[3]); *(uint2*)(O + (size_t)r * ldo + c) = w; } }
    }
};
struct EpiMerge {
    static constexpr bool PERM = false, AFTER_DRAIN = false;
    const bf16_t* gates; float* mer; bf16_t* merged; int g;
    __device__ __forceinline__ void operator()(const f32x4 (&acc)[2][2][4][2], const Unit& u, int wr, int wc, int fr, int fq) const {
        EPI_ROWS { const int r = EPI_R;
            EPI_COLS { const int c = EPI_C; float gt[4]; unpack4(*(const uint2*)(gates + (size_t)r * 4096 + g * 1024 + c), gt);
                f32x4 v = acc[ai][bj][m][n]; v[0] *= gt[0]; v[1] *= gt[1]; v[2] *= gt[2]; v[3] *= gt[3];
                float* mp = mer + (size_t)r * 1024 + c;
                if (g > 0) v += *(const f32x4*)mp;
                if (g < 3) *(f32x4*)mp = v;
                else { uint2 w; w.x = pk2(v[0], v[1]); w.y = pk2(v[2], v[3]); *(uint2*)(merged + (size_t)r * 1024 + c) = w; } }
            asm volatile("" ::: "memory"); }
    }
};
struct EpiRes {
    static constexpr bool PERM = false, AFTER_DRAIN = false;
    float* h; bf16_t* hb; float* ssn;
    __device__ __forceinline__ void operator()(const f32x4 (&acc)[2][2][4][2], const Unit& u, int wr, int wc, int fr, int fq) const {
        EPI_ROWS { const int r = EPI_R; float s = 0.f;
            EPI_COLS { const int c = EPI_C; float* hp = h + (size_t)r * 1024 + c; f32x4 v = *(const f32x4*)hp + acc[ai][bj][m][n]; *(f32x4*)hp = v;
                uint2 w; w.x = pk2(v[0], v[1]); w.y = pk2(v[2], v[3]); *(uint2*)(hb + (size_t)r * 1024 + c) = w;
                s += (v[0] * v[0] + v[1] * v[1]) + (v[2] * v[2] + v[3] * v[3]); }
            s += swz<16>(s); s += bperm((fq * 16 + fr) ^ 32, s);
            if (fq == 0) ssn[(size_t)r * 16 + u.pn * 4 + wc] = s;
            asm volatile("" ::: "memory"); }
    }
};
struct EpiGU {
    static constexpr bool PERM = false, AFTER_DRAIN = false;
    bf16_t* O; const float* ss;
    __device__ __forceinline__ void operator()(const f32x4 (&acc)[2][2][4][2], const Unit& u, int wr, int wc, int fr, int fq) const {
        EPI_ROWS { const int r = EPI_R; const float rstd = row_rstd(ss, r);
#pragma unroll
            for (int n = 0; n < 2; ++n) { const int c = u.pn * 128 + wc * 32 + n * 16 + 4 * fq; const f32x4 gg = acc[ai][0][m][n] * rstd, uu = acc[ai][1][m][n] * rstd;
                uint2 w; w.x = pk2(siluf_(gg[0]) * uu[0], siluf_(gg[1]) * uu[1]); w.y = pk2(siluf_(gg[2]) * uu[2], siluf_(gg[3]) * uu[3]); *(uint2*)(O + (size_t)r * DFF + c) = w; } }
    }
};
struct EpiF32 {
    static constexpr bool PERM = false, AFTER_DRAIN = false;
    float* C;
    __device__ __forceinline__ void operator()(const f32x4 (&acc)[2][2][4][2], const Unit& u, int wr, int wc, int fr, int fq) const {
        EPI_ROWS { const int r = EPI_R; EPI_COLS { const int c = EPI_C; *(f32x4*)(C + (size_t)r * 1024 + c) = acc[ai][bj][m][n]; } }
    }
};
struct EpiPG {
    static constexpr bool PERM = false, AFTER_DRAIN = false;
    float* h; bf16_t* hb; float* ssn; const float* ss; const float* pe;
    __device__ __forceinline__ void operator()(const f32x4 (&acc)[2][2][4][2], const Unit& u, int wr, int wc, int fr, int fq) const {
        EPI_ROWS { const int r = EPI_R; const float rstd = row_rstd(ss, r); float s = 0.f;
            EPI_COLS { const int c = EPI_C; float* hp = h + (size_t)r * 1024 + c; const f32x4 pv = *(const f32x4*)(pe + (size_t)r * 1024 + c); const f32x4 a = acc[ai][bj][m][n] * rstd;
                f32x4 v = *(const f32x4*)hp; v[0] += sigm(a[0]) * pv[0]; v[1] += sigm(a[1]) * pv[1]; v[2] += sigm(a[2]) * pv[2]; v[3] += sigm(a[3]) * pv[3]; *(f32x4*)hp = v;
                uint2 w; w.x = pk2(v[0], v[1]); w.y = pk2(v[2], v[3]); *(uint2*)(hb + (size_t)r * 1024 + c) = w;
                s += (v[0] * v[0] + v[1] * v[1]) + (v[2] * v[2] + v[3] * v[3]); }
            s += swz<16>(s); s += bperm((fq * 16 + fr) ^ 32, s);
            if (fq == 0) ssn[(size_t)r * 16 + u.pn * 4 + wc] = s;
            asm volatile("" ::: "memory"); }
    }
};
template <class Epi> __device__ __forceinline__ void run_gemm(int WV, unsigned char* shm, const bf16_t* A, const bf16_t* Bt, int N, int K, const Epi& E) {
    pg8::StaticOrder S; S.init(MT, N, (int)gridDim.x, obid());
    pg8::Gemm g{A, Bt, MT, N, K};
#ifndef NO_GEMM
    pg8::gemm_phase<Epi, pg8::StaticOrder, false>(WV, (PG8_LAS unsigned char*)shm, g, S, E, nullptr);
#endif
}

__device__ __forceinline__ void conv_tile(int WV, const float* src, int ldsrc, int K, int Nvalid, const float* gain, bf16_t* dst, int blk, int blkstride, int off, int kt, int ntile, float* sm) {
    const int tid = otid(WV), k0 = kt * 64, n0 = ntile * 64;
#pragma unroll
    for (int i = 0; i < 8; ++i) { const int idx = tid + 512 * i, kk = idx >> 6, jj = idx & 63, j = n0 + jj; float v = 0.f;
        if (j < Nvalid) { v = src[(size_t)(k0 + kk) * ldsrc + j]; if (gain) v *= gain[k0 + kk]; }
        sm[kk * 65 + jj] = v; }
    __syncthreads();
#pragma unroll
    for (int i = 0; i < 4; ++i) { const int idx = tid + 512 * i, jj = idx >> 5, kp = idx & 31, j = n0 + jj; const int drow = (j / blk) * blkstride + off + (j % blk);
        *(unsigned*)(dst + (size_t)drow * K + k0 + 2 * kp) = pk2(sm[(2 * kp) * 65 + jj], sm[(2 * kp + 1) * 65 + jj]); }
    __syncthreads();
}
constexpr int NCONV = 4800;
__device__ __forceinline__ void conv_job(int WV, const KP& p, int L, bf16_t* wb, int q, float* sm) {
    const float* src; int ld, K, Nv, blk = 1 << 30, bs = 0, off = 0, kt, nt; const float* gain = nullptr; bf16_t* dst;
    if (q < 832) { kt = q / 52; nt = q % 52; src = p.in[9] + (size_t)L * 1024 * 3096; ld = 3096; K = 1024; Nv = 3096; gain = p.in[8] + L * 1024; dst = wb + O_IN; }
    else if ((q -= 832) < 1024) { kt = q / 64; nt = q % 64; src = p.in[22] + (size_t)L * 1024 * 4096; ld = 4096; K = 1024; Nv = 4096; gain = p.in[8] + L * 1024; dst = wb + O_GATE; }
    else if ((q -= 1024) < 256) { const int g = q >> 6, r = q & 63; kt = r >> 4; nt = r & 15; src = p.in[23] + (size_t)(L * 4 + g) * 256 * 1024; ld = 1024; K = 256; Nv = 1024; dst = wb + O_BR + (size_t)g * 1024 * 256; }
    else if ((q -= 256) < 256) { kt = q >> 4; nt = q & 15; src = p.in[24] + (size_t)L * 1024 * 1024; ld = 1024; K = 1024; Nv = 1024; dst = wb + O_O; }
    else if ((q -= 256) < 704) { kt = q / 44; nt = q % 44; src = p.in[26] + (size_t)L * 1024 * DFF; ld = DFF; K = 1024; Nv = DFF; gain = p.in[25] + L * 1024; dst = wb + O_GU; blk = 128; bs = 256; off = 0; }
    else if ((q -= 704) < 704) { kt = q / 44; nt = q % 44; src = p.in[27] + (size_t)L * 1024 * DFF; ld = DFF; K = 1024; Nv = DFF; gain = p.in[25] + L * 1024; dst = wb + O_GU; blk = 128; bs = 256; off = 128; }
    else if ((q -= 704) < 704) { kt = q >> 4; nt = q & 15; src = p.in[28] + (size_t)L * DFF * 1024; ld = 1024; K = DFF; Nv = 1024; dst = wb + O_DN; }
    else if ((q -= 704) < 256) { kt = q >> 4; nt = q & 15; src = p.in[30] + (size_t)L * 1024 * 1024; ld = 1024; K = 1024; Nv = 1024; gain = p.in[29] + L * 1024; dst = wb + O_PG; }
    else { q -= 256; kt = q >> 4; nt = q & 15; src = p.in[31] + (size_t)L * 256 * 1024; ld = 1024; K = 256; Nv = 1024; dst = wb + O_PLE; }
    conv_tile(WV, src, ld, K, Nv, gain, dst, blk, bs, off, kt, nt, sm);
}

struct MX { const KP* p; int L; const bf16_t* proj; float* scr; bf16_t* br; };

__device__ __forceinline__ void gdn_partA(int WV, const KP& p, int L, const bf16_t* proj, float* scr, int item, float* sm) {
    const int tid = otid(WV), lane = tid & 63, wv = tid >> 6;
    const int h = item & 3, n = (item >> 2) & 31, b = item >> 7, t0 = b * 2048 + n * 64;
    float* sq = sm; float* sk = sq + 64 * 65; float* sv = sk + 64 * 65; float* sMm = sv + 64 * 65; float* sQK = sMm + 64 * 65; float* sX = sQK + 64 * 65; float* sG = sX + 64 * 129; float* sB = sG + 64;
    const float* cw = p.in[13] + (size_t)L * 4 * 768;
    for (int idx = tid; idx < 64 * 192; idx += 512) {
        const int l = idx / 192, cc = idx - l * 192, part = cc >> 6, ch = cc & 63, col = part * 256 + h * 64 + ch;
        float y = 0.f;
#pragma unroll
        for (int j = 0; j < 4; ++j) { const int tt = n * 64 + l - 3 + j; if (tt >= 0) y += cw[j * 768 + col] * bf2f(proj[(size_t)(b * 2048 + tt) * NINP + C_DQ + col]); }
        y = siluf_(y);
        (part == 0 ? sq : (part == 1 ? sk : sv))[l * 65 + ch] = y;
    }
    if (n == 31) for (int idx = tid; idx < 3 * 192; idx += 512) { const int j = idx / 192, cc = idx - j * 192, col = (cc >> 6) * 256 + h * 64 + (cc & 63);
        p.out[OUT_GCP + ((size_t)(L * 8 + b) * 3 + j) * 768 + col] = bf2f(proj[(size_t)(b * 2048 + 2045 + j) * NINP + C_DQ + col]); }
    if (tid < 64) {
        const float a = bf2f(proj[(size_t)(t0 + tid) * NINP + C_DA + h]), bb = bf2f(proj[(size_t)(t0 + tid) * NINP + C_DB + h]);
        float g = -__expf(p.in[14][L * 4 + h]) * softplusf_(a + p.in[15][L * 4 + h]);
        sB[tid] = sigm(bb);
#pragma unroll
        for (int o = 1; o < 64; o <<= 1) { const float t = bperm(tid - o, g); if (tid >= o) g += t; }
        sG[tid] = g;
    }
    __syncthreads();
    for (int i = 0; i < 8; ++i) { const int l = wv * 8 + i; const float x = sq[l * 65 + lane]; float s = wave_sum(x * x); sq[l * 65 + lane] = x * rsqrtf(s + EPSV) * 0.125f;
        const float y = sk[l * 65 + lane]; s = wave_sum(y * y); sk[l * 65 + lane] = y * rsqrtf(s + EPSV); }
    __syncthreads();
    const int ti = tid >> 4, tj = tid & 15, i0 = 2 * ti, j0 = 4 * tj;
    {
        float c1[2][4], c2[2][4];
#pragma unroll
        for (int a = 0; a < 2; ++a)
#pragma unroll
            for (int c = 0; c < 4; ++c) { c1[a][c] = 0.f; c2[a][c] = 0.f; }
#pragma unroll 4
        for (int kx = 0; kx < 64; ++kx) {
            const float a0 = sk[i0 * 65 + kx], a1 = sk[(i0 + 1) * 65 + kx], q0 = sq[i0 * 65 + kx], q1 = sq[(i0 + 1) * 65 + kx];
#pragma unroll
            for (int c = 0; c < 4; ++c) { const float bv = sk[(j0 + c) * 65 + kx]; c1[0][c] += a0 * bv; c1[1][c] += a1 * bv; c2[0][c] += q0 * bv; c2[1][c] += q1 * bv; }
        }
#pragma unroll
        for (int a = 0; a < 2; ++a)
#pragma unroll
            for (int c = 0; c < 4; ++c) { const int l = i0 + a, mm = j0 + c; const float dec = (mm <= l) ? __expf(sG[l] - sG[mm]) : 0.f;
                sMm[l * 65 + mm] = (mm < l) ? sB[l] * dec * c1[a][c] : 0.f; sQK[l * 65 + mm] = dec * c2[a][c]; }
        for (int idx = tid; idx < 64 * 128; idx += 512) { const int l = idx >> 7, col = idx & 127;
            sX[l * 129 + col] = (col < 64) ? sB[l] * sv[l * 65 + col] : sB[l] * __expf(sG[l]) * sk[l * 65 + col - 64]; }
    }
    __syncthreads();
    for (int I = 0; I < 4; ++I) { const int r0 = I * 16, r1 = r0 + 16;
        if (tid < 128) { for (int l = 1; l < 16; ++l) { float acc = sX[(r0 + l) * 129 + tid]; for (int mm = 0; mm < l; ++mm) acc -= sMm[(r0 + l) * 65 + r0 + mm] * sX[(r0 + mm) * 129 + tid]; sX[(r0 + l) * 129 + tid] = acc; } }
        __syncthreads();
        for (int idx = tid; idx < (64 - r1) * 128; idx += 512) { const int r = r1 + (idx >> 7), col = idx & 127; float acc = sX[r * 129 + col];
#pragma unroll 4
            for (int mm = r0; mm < r1; ++mm) acc -= sMm[r * 65 + mm] * sX[mm * 129 + col];
            sX[r * 129 + col] = acc; }
        __syncthreads();
    }
    const float g63 = sG[63];
    for (int idx = tid; idx < 64 * 64; idx += 512) { const int l = idx >> 6, c = idx & 63; sk[l * 65 + c] *= __expf(g63 - sG[l]); }
    __syncthreads();
    {
        float cT[2][4], cR[2][4], cQ[2][4], cO[2][4];
#pragma unroll
        for (int a = 0; a < 2; ++a)
#pragma unroll
            for (int c = 0; c < 4; ++c) { cT[a][c] = 0.f; cR[a][c] = 0.f; cQ[a][c] = 0.f; cO[a][c] = 0.f; }
#pragma unroll 2
        for (int l = 0; l < 64; ++l) {
            const float k0 = sk[l * 65 + i0], k1 = sk[l * 65 + i0 + 1], e0 = sQK[i0 * 65 + l], e1 = sQK[(i0 + 1) * 65 + l];
#pragma unroll
            for (int c = 0; c < 4; ++c) { const float wv_ = sX[l * 129 + 64 + j0 + c], uv = sX[l * 129 + j0 + c];
                cT[0][c] += k0 * wv_; cT[1][c] += k1 * wv_; cR[0][c] += k0 * uv; cR[1][c] += k1 * uv; cQ[0][c] += e0 * wv_; cQ[1][c] += e1 * wv_; cO[0][c] += e0 * uv; cO[1][c] += e1 * uv; }
        }
        const float dn = __expf(g63);
#pragma unroll
        for (int a = 0; a < 2; ++a) { const int i = i0 + a; const float eg = __expf(sG[i]); f32x4 vT, vR, vQ, vO;
#pragma unroll
            for (int c = 0; c < 4; ++c) { vT[c] = ((i == j0 + c) ? dn : 0.f) - cT[a][c]; vR[c] = cR[a][c]; vQ[c] = sq[i * 65 + j0 + c] * eg - cQ[a][c]; vO[c] = cO[a][c]; }
            const size_t o = (size_t)item * 4096 + i * 64 + j0;
            *(f32x4*)(scr + SC_GT + o) = vT; *(f32x4*)(scr + SC_GR + o) = vR; *(f32x4*)(scr + SC_GQ + o) = vQ; *(f32x4*)(scr + SC_GO + o) = vO; }
    }
    __syncthreads();
}
__device__ __forceinline__ void gdn_scan(int WV, const KP& p, int L, float* scr, int job, float* sm) {
    const int tid = otid(WV), bh = job >> 3, vs = job & 7, b = bh >> 2, h = bh & 3, k = tid >> 3, j = tid & 7, col = vs * 8 + j;
    float* S0 = sm; float* S1 = sm + 512;
    S0[tid] = 0.f;
    __syncthreads();
    f32x4 tc[16];
    { const float* tp = scr + SC_GT + (size_t)((b * 32 + 0) * 4 + h) * 4096 + k * 64;
#pragma unroll
      for (int i = 0; i < 16; ++i) tc[i] = *(const f32x4*)(tp + 4 * i); }
    for (int n = 0; n < 32; ++n) {
        const size_t item = (size_t)((b * 32 + n) * 4 + h);
        f32x4 tn[16];
        { const float* tp = scr + SC_GT + (size_t)((b * 32 + (n < 31 ? n + 1 : n)) * 4 + h) * 4096 + k * 64;
#pragma unroll
          for (int i = 0; i < 16; ++i) tn[i] = *(const f32x4*)(tp + 4 * i); }
        const float* Sc = (n & 1) ? S1 : S0; float* Sn = (n & 1) ? S0 : S1;
        float acc = scr[SC_GR + item * 4096 + k * 64 + col];
        scr[SC_GS + item * 4096 + k * 64 + col] = Sc[k * 8 + j];
#pragma unroll
        for (int i = 0; i < 16; ++i) acc += tc[i][0] * Sc[(4 * i) * 8 + j] + tc[i][1] * Sc[(4 * i + 1) * 8 + j] + tc[i][2] * Sc[(4 * i + 2) * 8 + j] + tc[i][3] * Sc[(4 * i + 3) * 8 + j];
        Sn[k * 8 + j] = acc;
        __syncthreads();
#pragma unroll
        for (int i = 0; i < 16; ++i) tc[i] = tn[i];
    }
    p.out[OUT_GDNP + (size_t)((L * 8 + b) * 4 + h) * 4096 + k * 64 + col] = S0[k * 8 + j];
    __syncthreads();
}
__device__ __forceinline__ void gdn_partB(int WV, const KP& p, int L, const bf16_t* proj, const float* scr, bf16_t* br, int item, float* sm) {
    const int tid = otid(WV), h = item & 3, n = (item >> 2) & 31, b = item >> 7, t0 = b * 2048 + n * 64;
    float* sA = sm; float* sS = sm + 64 * 65;
    for (int idx = tid; idx < 4096; idx += 512) { const int r = idx >> 6, c = idx & 63; sA[r * 65 + c] = scr[SC_GQ + (size_t)item * 4096 + idx]; sS[r * 65 + c] = scr[SC_GS + (size_t)item * 4096 + idx]; }
    __syncthreads();
    const int ti = tid >> 4, tj = tid & 15, i0 = 2 * ti, j0 = 4 * tj;
    float o[2][4];
#pragma unroll
    for (int a = 0; a < 2; ++a) { const f32x4 v = *(const f32x4*)(scr + SC_GO + (size_t)item * 4096 + (i0 + a) * 64 + j0); o[a][0] = v[0]; o[a][1] = v[1]; o[a][2] = v[2]; o[a][3] = v[3]; }
#pragma unroll 4
    for (int kx = 0; kx < 64; ++kx) { const float a0 = sA[i0 * 65 + kx], a1 = sA[(i0 + 1) * 65 + kx];
#pragma unroll
        for (int c = 0; c < 4; ++c) { const float bv = sS[kx * 65 + j0 + c]; o[0][c] += a0 * bv; o[1][c] += a1 * bv; } }
    const float* gn = p.in[16] + L * 64;
#pragma unroll
    for (int a = 0; a < 2; ++a) { float s = o[a][0] * o[a][0] + o[a][1] * o[a][1] + o[a][2] * o[a][2] + o[a][3] * o[a][3];
        s += swz<1>(s); s += swz<2>(s); s += swz<4>(s); s += swz<8>(s);
        const float rs = rsqrtf(s * (1.f / 64.f) + EPSV); const int row = t0 + i0 + a;
        float z[4]; unpack4(*(const uint2*)(proj + (size_t)row * NINP + C_DZ + h * 64 + j0), z);
        float y[4];
#pragma unroll
        for (int c = 0; c < 4; ++c) y[c] = o[a][c] * rs * gn[j0 + c] * siluf_(z[c]);
        uint2 w; w.x = pk2(y[0], y[1]); w.y = pk2(y[2], y[3]); *(uint2*)(br + (size_t)1 * MT * 256 + (size_t)row * 256 + h * 64 + j0) = w; }
    __syncthreads();
}
__device__ __forceinline__ void gla_load(int WV, const KP& p, int L, const bf16_t* proj, int item, float* sm) {
    const int tid = otid(WV), h = item & 3, n = (item >> 2) & 31, b = item >> 7, t0 = b * 2048 + n * 64;
    float* sq = sm; float* sk = sq + 64 * 33; float* sb = sk + 64 * 33; float* sv = sb + 64 * 33; float* sga = sv + 64 * 65;
    for (int idx = tid; idx < 64 * 32; idx += 512) { const int l = idx >> 5, c = idx & 31; const size_t ro = (size_t)(t0 + l) * NINP;
        sq[l * 33 + c] = bf2f(proj[ro + C_GQ + h * 32 + c]) * 0.17677669529663687f; sk[l * 33 + c] = bf2f(proj[ro + C_GK + h * 32 + c]); }
    for (int idx = tid; idx < 64 * 64; idx += 512) { const int l = idx >> 6, c = idx & 63; sv[l * 65 + c] = bf2f(proj[(size_t)(t0 + l) * NINP + C_GV + h * 64 + c]); }
    for (int idx = tid; idx < 64 * 16; idx += 512) { const int l = idx >> 4, c = idx & 15; sga[l * 17 + c] = bf2f(proj[(size_t)(t0 + l) * NINP + C_GA + c]); }
    __syncthreads();
    const float* wa2 = p.in[10] + (size_t)L * 16 * 128; const float* ba = p.in[11] + L * 128;
    for (int idx = tid; idx < 64 * 32; idx += 512) { const int l = idx >> 5, c = idx & 31; float x = ba[h * 32 + c];
#pragma unroll
        for (int r = 0; r < 16; ++r) x += sga[l * 17 + r] * wa2[r * 128 + h * 32 + c];
        sb[l * 33 + c] = logsigm(x) * (1.f / 16.f); }
    __syncthreads();
    if (tid < 32) { float a = 0.f; for (int l = 0; l < 64; ++l) { a += sb[l * 33 + tid]; sb[l * 33 + tid] = a; } }
    __syncthreads();
}
__device__ __forceinline__ void gla_partA(int WV, const KP& p, int L, const bf16_t* proj, float* scr, int item, float* sm) {
    gla_load(WV, p, L, proj, item, sm);
    const int tid = otid(WV);
    float* sk = sm + 64 * 33; float* sb = sk + 64 * 33; float* sv = sb + 64 * 33;
    const int kk = tid >> 4, v0 = (tid & 15) * 4; const float bl = sb[63 * 33 + kk];
    float acc[4] = {0.f, 0.f, 0.f, 0.f};
#pragma unroll 4
    for (int l = 0; l < 64; ++l) { const float ke = sk[l * 33 + kk] * __expf(bl - sb[l * 33 + kk]);
#pragma unroll
        for (int c = 0; c < 4; ++c) acc[c] += ke * sv[l * 65 + v0 + c]; }
    *(f32x4*)(scr + SC_ADS + (size_t)item * 2048 + kk * 64 + v0) = (f32x4){acc[0], acc[1], acc[2], acc[3]};
    if (tid < 32) scr[SC_ADEC + (size_t)item * 32 + tid] = __expf(sb[63 * 33 + tid]);
    __syncthreads();
}
__device__ __forceinline__ void gla_partB(int WV, const KP& p, int L, const bf16_t* proj, const float* scr, bf16_t* br, int item, float* sm) {
    gla_load(WV, p, L, proj, item, sm);
    const int tid = otid(WV), h = item & 3, n = (item >> 2) & 31, b = item >> 7, t0 = b * 2048 + n * 64;
    float* sq = sm; float* sk = sq + 64 * 33; float* sb = sk + 64 * 33; float* sv = sb + 64 * 33; float* sA = sv + 64 * 65 + 64 * 17; float* sS = sA + 64 * 65;
    for (int idx = tid; idx < 64 * 32; idx += 512) { const int l = idx >> 5, c = idx & 31; const float bb = sb[l * 33 + c]; sq[l * 33 + c] *= __expf(bb); sk[l * 33 + c] *= __expf(-bb); }
    for (int idx = tid; idx < 2048; idx += 512) { sS[(idx >> 6) * 65 + (idx & 63)] = scr[SC_AS + (size_t)item * 2048 + idx]; }
    __syncthreads();
    const int ti = tid >> 4, tj = tid & 15, i0 = 2 * ti, j0 = 4 * tj;
    {
        float c1[2][4];
#pragma unroll
        for (int a = 0; a < 2; ++a)
#pragma unroll
            for (int c = 0; c < 4; ++c) c1[a][c] = 0.f;
#pragma unroll 4
        for (int kx = 0; kx < 32; ++kx) { const float a0 = sq[i0 * 33 + kx], a1 = sq[(i0 + 1) * 33 + kx];
#pragma unroll
            for (int c = 0; c < 4; ++c) { const float bv = sk[(j0 + c) * 33 + kx]; c1[0][c] += a0 * bv; c1[1][c] += a1 * bv; } }
#pragma unroll
        for (int a = 0; a < 2; ++a)
#pragma unroll
            for (int c = 0; c < 4; ++c) sA[(i0 + a) * 65 + j0 + c] = (j0 + c <= i0 + a) ? c1[a][c] : 0.f;
    }
    __syncthreads();
    float o[2][4];
#pragma unroll
    for (int a = 0; a < 2; ++a)
#pragma unroll
        for (int c = 0; c < 4; ++c) o[a][c] = 0.f;
#pragma unroll 4
    for (int mm = 0; mm < 64; ++mm) { const float a0 = sA[i0 * 65 + mm], a1 = sA[(i0 + 1) * 65 + mm];
#pragma unroll
        for (int c = 0; c < 4; ++c) { const float bv = sv[mm * 65 + j0 + c]; o[0][c] += a0 * bv; o[1][c] += a1 * bv; } }
#pragma unroll 4
    for (int kx = 0; kx < 32; ++kx) { const float a0 = sq[i0 * 33 + kx], a1 = sq[(i0 + 1) * 33 + kx];
#pragma unroll
        for (int c = 0; c < 4; ++c) { const float bv = sS[kx * 65 + j0 + c]; o[0][c] += a0 * bv; o[1][c] += a1 * bv; } }
    const float* gn = p.in[12] + L * 64;
#pragma unroll
    for (int a = 0; a < 2; ++a) { float s = o[a][0] * o[a][0] + o[a][1] * o[a][1] + o[a][2] * o[a][2] + o[a][3] * o[a][3];
        s += swz<1>(s); s += swz<2>(s); s += swz<4>(s); s += swz<8>(s);
        const float rs = rsqrtf(s * (1.f / 64.f) + EPSV); const int row = t0 + i0 + a;
        float z[4]; unpack4(*(const uint2*)(proj + (size_t)row * NINP + C_GR + h * 64 + j0), z);
        float y[4];
#pragma unroll
        for (int c = 0; c < 4; ++c) y[c] = o[a][c] * rs * gn[j0 + c] * siluf_(z[c]);
        uint2 w; w.x = pk2(y[0], y[1]); w.y = pk2(y[2], y[3]); *(uint2*)(br + (size_t)row * 256 + h * 64 + j0) = w; }
    __syncthreads();
}
__device__ __forceinline__ void cm_prompt(int WV, const KP& p, int L, const bf16_t* proj, bf16_t* br, int item, float* sm) {
    const int tid = otid(WV), lane = tid & 63, wv = tid >> 6, g = item & 3, n = (item >> 2) & 15, b = item >> 6, t0 = b * 2048 + n * 128;
    float* sW = sm; float* sV = sW + 128 * 129;
    const float* lg = p.in[17] + L * 256; const float* lb = p.in[18] + L * 256;
    for (int i = 0; i < 16; ++i) { const int t = wv * 16 + i; float x[4]; unpack4(*(const uint2*)(proj + (size_t)(t0 + t) * NINP + C_CV + lane * 4), x);
#pragma unroll
        for (int c = 0; c < 4; ++c) x[c] = geluf_(x[c]);
        const float mean = wave_sum((x[0] + x[1]) + (x[2] + x[3])) * (1.f / 256.f);
        float d2 = 0.f;
#pragma unroll
        for (int c = 0; c < 4; ++c) { x[c] -= mean; d2 += x[c] * x[c]; }
        const float rstd = rsqrtf(wave_sum(d2) * (1.f / 256.f) + EPSV);
        if ((lane >> 4) == g) {
#pragma unroll
            for (int c = 0; c < 4; ++c) { const int ch = lane * 4 + c; sV[t * 65 + (ch & 63)] = x[c] * rstd * lg[ch] + lb[ch]; } } }
    const float* wsrc = p.in[19] + (size_t)(L * 4 + g) * 128 * 128;
    for (int idx = tid; idx < 128 * 128; idx += 512) { const int t = idx >> 7, s = idx & 127; sW[t * 129 + s] = (s <= t) ? wsrc[idx] : 0.f; }
    __syncthreads();
    const int ti = tid >> 4, tj = tid & 15, i0 = 4 * ti, j0 = 4 * tj;
    float acc[4][4];
#pragma unroll
    for (int a = 0; a < 4; ++a)
#pragma unroll
        for (int c = 0; c < 4; ++c) acc[a][c] = 0.f;
    for (int s = 0; s < i0 + 4; ++s) { float av[4], bv[4];
#pragma unroll
        for (int a = 0; a < 4; ++a) av[a] = sW[(i0 + a) * 129 + s];
#pragma unroll
        for (int c = 0; c < 4; ++c) bv[c] = sV[s * 65 + j0 + c];
#pragma unroll
        for (int a = 0; a < 4; ++a)
#pragma unroll
            for (int c = 0; c < 4; ++c) acc[a][c] += av[a] * bv[c]; }
    const float* bs = p.in[20] + (size_t)(L * 4 + g) * 128;
#pragma unroll
    for (int a = 0; a < 4; ++a) { const int t = i0 + a, row = t0 + t; float uu[4]; unpack4(*(const uint2*)(proj + (size_t)row * NINP + C_CU + g * 64 + j0), uu);
        const float bt = bs[t]; float y[4];
#pragma unroll
        for (int c = 0; c < 4; ++c) y[c] = geluf_(uu[c]) * (acc[a][c] + bt);
        uint2 w; w.x = pk2(y[0], y[1]); w.y = pk2(y[2], y[3]); *(uint2*)(br + (size_t)2 * MT * 256 + (size_t)row * 256 + g * 64 + j0) = w; }
    __syncthreads();
}
__device__ __forceinline__ void cm_sample(int WV, const KP& p, int L, const bf16_t* proj, bf16_t* br, int b, float* sm) {
    const int tid = otid(WV), lane = tid & 63, t = tid >> 6, row = MPR + b * 8 + t;
    const float* lg = p.in[17] + L * 256; const float* lb = p.in[18] + L * 256;
    float x[4]; unpack4(*(const uint2*)(proj + (size_t)row * NINP + C_CV + lane * 4), x);
#pragma unroll
    for (int c = 0; c < 4; ++c) x[c] = geluf_(x[c]);
    const float mean = wave_sum((x[0] + x[1]) + (x[2] + x[3])) * (1.f / 256.f);
    float d2 = 0.f;
#pragma unroll
    for (int c = 0; c < 4; ++c) { x[c] -= mean; d2 += x[c] * x[c]; }
    const float rstd = rsqrtf(wave_sum(d2) * (1.f / 256.f) + EPSV);
    f32x4 vn;
#pragma unroll
    for (int c = 0; c < 4; ++c) { const int ch = lane * 4 + c; vn[c] = x[c] * rstd * lg[ch] + lb[ch]; sm[t * 256 + ch] = vn[c]; }
    *(f32x4*)(p.out + OUT_CVS + ((size_t)(L * 128 + b) * 8 + t) * 256 + lane * 4) = vn;
    __syncthreads();
    const int g = lane >> 4; const float* wsrc = p.in[19] + (size_t)(L * 4 + g) * 128 * 128 + t * 128; const float bt = p.in[20][(size_t)(L * 4 + g) * 128 + t];
    float s4[4] = {bt, bt, bt, bt};
    for (int s = 0; s <= t; ++s) { const float w = wsrc[s];
#pragma unroll
        for (int c = 0; c < 4; ++c) s4[c] += w * sm[s * 256 + lane * 4 + c]; }
    float uu[4]; unpack4(*(const uint2*)(proj + (size_t)row * NINP + C_CU + lane * 4), uu);
    uint2 w; w.x = pk2(geluf_(uu[0]) * s4[0], geluf_(uu[1]) * s4[1]); w.y = pk2(geluf_(uu[2]) * s4[2], geluf_(uu[3]) * s4[3]);
    *(uint2*)(br + (size_t)2 * MT * 256 + (size_t)row * 256 + lane * 4) = w;
    __syncthreads();
}
__device__ __forceinline__ void sconv_elem(const KP& p, int L, const bf16_t* proj, bf16_t* br, int idx) {
    const int r = idx >> 6, c4 = (idx & 63) * 4; const bool prm = r < MPR; const int b = prm ? (r >> 11) : ((r - MPR) >> 3), t = prm ? (r & 2047) : ((r - MPR) & 7), T = prm ? 2048 : 8;
    float g0[4], g1[4], g2[4], a[4], bb[4];
    { unpack4(*(const uint2*)(proj + (size_t)r * NINP + C_SC + c4), a); unpack4(*(const uint2*)(proj + (size_t)r * NINP + C_SH + c4), bb);
#pragma unroll
      for (int c = 0; c < 4; ++c) g0[c] = a[c] * bb[c]; }
    const float* st = p.in[5] + (size_t)(L * 128 + b) * 2 * 256;
    if (t >= 1) { unpack4(*(const uint2*)(proj + (size_t)(r - 1) * NINP + C_SC + c4), a); unpack4(*(const uint2*)(proj + (size_t)(r - 1) * NINP + C_SH + c4), bb);
#pragma unroll
        for (int c = 0; c < 4; ++c) g1[c] = a[c] * bb[c]; }
    else {
#pragma unroll
        for (int c = 0; c < 4; ++c) g1[c] = prm ? 0.f : st[256 + c4 + c]; }
    if (t >= 2) { unpack4(*(const uint2*)(proj + (size_t)(r - 2) * NINP + C_SC + c4), a); unpack4(*(const uint2*)(proj + (size_t)(r - 2) * NINP + C_SH + c4), bb);
#pragma unroll
        for (int c = 0; c < 4; ++c) g2[c] = a[c] * bb[c]; }
    else {
#pragma unroll
        for (int c = 0; c < 4; ++c) g2[c] = prm ? 0.f : st[t * 256 + c4 + c]; }
    const float* w = p.in[21] + (size_t)L * 3 * 256; float sb4[4]; unpack4(*(const uint2*)(proj + (size_t)r * NINP + C_SB + c4), sb4);
    float y[4];
#pragma unroll
    for (int c = 0; c < 4; ++c) y[c] = sb4[c] * (w[c4 + c] * g2[c] + w[256 + c4 + c] * g1[c] + w[512 + c4 + c] * g0[c]);
    uint2 o; o.x = pk2(y[0], y[1]); o.y = pk2(y[2], y[3]); *(uint2*)(br + (size_t)3 * MT * 256 + (size_t)r * 256 + c4) = o;
    if (t >= T - 2) { float* dst = p.out + (prm ? OUT_SCP + ((size_t)(L * 8 + b) * 2 + (t - (T - 2))) * 256 : OUT_SCS + ((size_t)(L * 128 + b) * 2 + (t - (T - 2))) * 256) + c4;
        *(f32x4*)dst = (f32x4){g0[0], g0[1], g0[2], g0[3]}; }
}
__device__ __forceinline__ void gla_sample(int WV, const KP& p, int L, const bf16_t* proj, bf16_t* br, int wi, float* sm) {
    const int tid = otid(WV), lane = tid & 63, b = wi >> 2, h = wi & 3, kk = lane & 31; float* wl = sm + (tid >> 6) * 128;
    float S[32];
    const float* s0 = p.in[2] + (size_t)((L * 128 + b) * 4 + h) * 2048 + lane;
#pragma unroll
    for (int k = 0; k < 32; ++k) S[k] = s0[k * 64];
    const float* wa2 = p.in[10] + (size_t)L * 16 * 128; const float bav = p.in[11][L * 128 + h * 32 + kk]; const float gnv = p.in[12][L * 64 + lane];
    for (int t = 0; t < 8; ++t) { const size_t ro = (size_t)(MPR + b * 8 + t) * NINP;
        const float qv = bf2f(proj[ro + C_GQ + h * 32 + kk]) * 0.17677669529663687f, kv = bf2f(proj[ro + C_GK + h * 32 + kk]);
        float x = bav;
#pragma unroll
        for (int r = 0; r < 16; ++r) x += bf2f(proj[ro + C_GA + r]) * wa2[r * 128 + h * 32 + kk];
        const float av = __expf(logsigm(x) * (1.f / 16.f));
        const float v = bf2f(proj[ro + C_GV + h * 64 + lane]);
        float o = 0.f;
        if (lane < 32) { wl[lane] = av; wl[32 + lane] = kv; wl[64 + lane] = qv; }
        __builtin_amdgcn_wave_barrier();
#pragma unroll
        for (int k4 = 0; k4 < 8; ++k4) { const f32x4 a4 = *(const f32x4*)(wl + 4 * k4), k4v = *(const f32x4*)(wl + 32 + 4 * k4), q4 = *(const f32x4*)(wl + 64 + 4 * k4);
#pragma unroll
            for (int c = 0; c < 4; ++c) { S[4 * k4 + c] = a4[c] * S[4 * k4 + c] + k4v[c] * v; o += q4[c] * S[4 * k4 + c]; } }
        __builtin_amdgcn_wave_barrier();
        const float rs = rsqrtf(wave_sum(o * o) * (1.f / 64.f) + EPSV);
        const float y = o * rs * gnv * siluf_(bf2f(proj[ro + C_GR + h * 64 + lane]));
        br[(size_t)(MPR + b * 8 + t) * 256 + h * 64 + lane] = (bf16_t)(pk2(y, 0.f) & 0xffffu);
    }
    const int lane2 = otid(WV) & 63;
    float* so = p.out + OUT_GLAS + (size_t)((L * 128 + b) * 4 + h) * 2048 + lane2;
#pragma unroll
    for (int k = 0; k < 32; ++k) so[k * 64] = S[k];
}
__device__ __forceinline__ void gdn_sample(int WV, const KP& p, int L, const bf16_t* proj, bf16_t* br, int wi, float* sm) {
    const int tid = otid(WV), lane = tid & 63, b = wi >> 2, h = wi & 3; float* wl = sm + (tid >> 6) * 128;
    float S[64];
    const float* s0 = p.in[3] + (size_t)((L * 128 + b) * 4 + h) * 4096 + lane;
#pragma unroll
    for (int k = 0; k < 64; ++k) S[k] = s0[k * 64];
    const float* cw = p.in[13] + (size_t)L * 4 * 768; const float* cb = p.in[4] + (size_t)(L * 128 + b) * 3 * 768;
    float w[3][4], xm[3][3];
#pragma unroll
    for (int pt = 0; pt < 3; ++pt) { const int col = pt * 256 + h * 64 + lane;
#pragma unroll
        for (int j = 0; j < 4; ++j) w[pt][j] = cw[j * 768 + col];
#pragma unroll
        for (int j = 0; j < 3; ++j) xm[pt][j] = cb[j * 768 + col]; }
    const float nal = -__expf(p.in[14][L * 4 + h]), dtb = p.in[15][L * 4 + h], gnv = p.in[16][L * 64 + lane];
    for (int t = 0; t < 8; ++t) { const int row = MPR + b * 8 + t; const size_t ro = (size_t)row * NINP;
        float y[3];
#pragma unroll
        for (int pt = 0; pt < 3; ++pt) { const float xc = bf2f(proj[ro + C_DQ + pt * 256 + h * 64 + lane]);
            y[pt] = siluf_(w[pt][0] * xm[pt][0] + w[pt][1] * xm[pt][1] + w[pt][2] * xm[pt][2] + w[pt][3] * xc);
            xm[pt][0] = xm[pt][1]; xm[pt][1] = xm[pt][2]; xm[pt][2] = xc; }
        const float q = y[0] * rsqrtf(wave_sum(y[0] * y[0]) + EPSV) * 0.125f, kx = y[1] * rsqrtf(wave_sum(y[1] * y[1]) + EPSV), v = y[2];
        const float eg = __expf(nal * softplusf_(bf2f(proj[ro + C_DA + h]) + dtb)), beta = sigm(bf2f(proj[ro + C_DB + h]));
        float kS = 0.f;
        wl[lane] = kx; wl[64 + lane] = q;
        __builtin_amdgcn_wave_barrier();
#pragma unroll
        for (int k4 = 0; k4 < 16; ++k4) { const f32x4 k4v = *(const f32x4*)(wl + 4 * k4);
#pragma unroll
            for (int c = 0; c < 4; ++c) kS += k4v[c] * S[4 * k4 + c]; }
        const float wv_ = beta * (v - eg * kS);
        float o = 0.f;
#pragma unroll
        for (int k4 = 0; k4 < 16; ++k4) { const f32x4 k4v = *(const f32x4*)(wl + 4 * k4), q4 = *(const f32x4*)(wl + 64 + 4 * k4);
#pragma unroll
            for (int c = 0; c < 4; ++c) { S[4 * k4 + c] = eg * S[4 * k4 + c] + k4v[c] * wv_; o += q4[c] * S[4 * k4 + c]; } }
        __builtin_amdgcn_wave_barrier();
        const float rs = rsqrtf(wave_sum(o * o) * (1.f / 64.f) + EPSV);
        const float yo = o * rs * gnv * siluf_(bf2f(proj[ro + C_DZ + h * 64 + lane]));
        br[(size_t)MT * 256 + (size_t)row * 256 + h * 64 + lane] = (bf16_t)(pk2(yo, 0.f) & 0xffffu);
    }
    const int lane2 = otid(WV) & 63;
    float* so = p.out + OUT_GDNS + (size_t)((L * 128 + b) * 4 + h) * 4096 + lane2;
#pragma unroll
    for (int k = 0; k < 64; ++k) so[k * 64] = S[k];
    float* co = p.out + OUT_GCS + (size_t)(L * 128 + b) * 3 * 768 + h * 64 + lane2;
#pragma unroll
    for (int pt = 0; pt < 3; ++pt)
#pragma unroll
        for (int j = 0; j < 3; ++j) co[j * 768 + pt * 256] = xm[pt][j];
}

__device__ __forceinline__ const KP& okp() { const __attribute__((address_space(4))) KP* q = (const __attribute__((address_space(4))) KP*)__builtin_amdgcn_kernarg_segment_ptr(); asm volatile("" : "+s"(q)); return *(const KP*)q; }
#define PH_BEGIN { const KP& p = okp(); int WV_ = WV0, nb_ = nb0; asm volatile("" : "+s"(WV_), "+s"(nb_)); const int WV = WV_, nb = nb_; const int bid = obid(), tid = otid(WV), lane = tid & 63, wv = tid >> 6; (void)lane; (void)wv; (void)bid; (void)nb; \
    bf16_t* proj = (bf16_t*)(p.ws + WS_PROJ); bf16_t* gates = (bf16_t*)(p.ws + WS_GATES); float* scr = (float*)(p.ws + WS_GATES); bf16_t* actb = (bf16_t*)(p.ws + WS_GATES); \
    bf16_t* hb = (bf16_t*)(p.ws + ((L & 1) ? WS_HB2 : WS_HB)); bf16_t* hb2 = (bf16_t*)(p.ws + ((L & 1) ? WS_HB : WS_HB2)); (void)hb2; bf16_t* br = (bf16_t*)(p.ws + WS_BR); bf16_t* pb = (bf16_t*)(p.ws + WS_PB); float* ss = (float*)(p.ws + WS_SS); \
    float* mer = (float*)(p.ws + WS_PROJ + PR_MER); bf16_t* merged = (bf16_t*)(p.ws + WS_PROJ + PR_MERGED); float* pe = (float*)(p.ws + WS_PROJ); float* h = p.out; \
    const bf16_t* wb = (const bf16_t*)(p.ws + ((L & 1) ? WS_W1 : WS_W0)); \
    const float* ss0 = ss + (size_t)(3 * L) * MT * 16; float* ss1 = ss + (size_t)(3 * L + 1) * MT * 16; float* ss2 = ss + (size_t)(3 * L + 2) * MT * 16; float* ss3 = ss + (size_t)(3 * L + 3) * MT * 16; \
    (void)proj; (void)gates; (void)scr; (void)actb; (void)hb; (void)br; (void)pb; (void)ss; (void)mer; (void)merged; (void)pe; (void)h; (void)wb; (void)ss0; (void)ss1; (void)ss2; (void)ss3;
#define PH_END }
__global__ void __launch_bounds__(512, 2) mega(KP p_unused) {
    extern __shared__ __attribute__((aligned(16))) unsigned char shm[];
    cg::grid_group grid = cg::this_grid();
    float* sm = (float*)shm;
    const int nb0 = gridDim.x, WV0 = __builtin_amdgcn_readfirstlane(threadIdx.x >> 6);
    { const int L = 0;
    PH_BEGIN
    for (int q = bid; q < NCONV; q += nb) conv_job(WV, p, 0, (bf16_t*)(p.ws + WS_W0), q, sm);
    for (int r = bid * 8 + wv; r < MT; r += nb * 8) {
        const float* xr = (r < MPR) ? p.in[0] + (size_t)r * 1024 : p.in[1] + (size_t)(r - MPR) * 1024; float s = 0.f;
#pragma unroll
        for (int j = 0; j < 4; ++j) { const f32x4 v = *(const f32x4*)(xr + j * 256 + lane * 4); *(f32x4*)(h + (size_t)r * 1024 + j * 256 + lane * 4) = v;
            uint2 w; w.x = pk2(v[0], v[1]); w.y = pk2(v[2], v[3]); *(uint2*)(hb + (size_t)r * 1024 + j * 256 + lane * 4) = w; s += (v[0] * v[0] + v[1] * v[1]) + (v[2] * v[2] + v[3] * v[3]); }
        s = wave_sum(s); if (lane < 16) ss[(size_t)r * 16 + lane] = (lane == 0) ? s : 0.f;
    }
    PH_END }
    grid.sync();
#pragma nounroll
    for (int L = 0; L < 4; ++L) {
        PH_BEGIN { EpiProj E{proj, NINP, ss0, 0}; run_gemm(WV, shm, hb, wb + O_IN, NINP, 1024, E); } PH_END
        grid.sync();
        PH_BEGIN
        for (int it = bid; it < 1024; it += nb) gdn_partA(WV, p, L, proj, scr, it, sm);
        for (int it = bid; it < 1024; it += nb) gla_partA(WV, p, L, proj, scr, it, sm);
        for (int it = bid; it < 512; it += nb) cm_prompt(WV, p, L, proj, br, it, sm);
        for (int it = bid; it < 128; it += nb) cm_sample(WV, p, L, proj, br, it, sm);
        for (int it = bid; it < 64; it += nb) gla_sample(WV, p, L, proj, br, it * 8 + wv, sm);
        for (int it = bid; it < 64; it += nb) gdn_sample(WV, p, L, proj, br, it * 8 + wv, sm);
        for (int i = bid * 512 + tid; i < MT * 64; i += nb * 512) sconv_elem(p, L, proj, br, i);
        PH_END
        grid.sync();
        PH_BEGIN
        for (int job = bid; job < 256; job += nb) gdn_scan(WV, p, L, scr, job, sm);
        for (int e = bid * 512 + tid; e < 65536; e += nb * 512) { const int bh = e >> 11, kv = e & 2047, kk = kv >> 6, b = bh >> 2, hh = bh & 3; float S = 0.f;
            for (int n = 0; n < 32; ++n) { const size_t item = (size_t)((b * 32 + n) * 4 + hh); scr[SC_AS + item * 2048 + kv] = S; S = scr[SC_ADEC + item * 32 + kk] * S + scr[SC_ADS + item * 2048 + kv]; }
            p.out[OUT_GLAP + (size_t)((L * 8 + b) * 4 + hh) * 2048 + kv] = S; }
        if (L < 3) for (int q = bid; q < NCONV; q += nb) conv_job(WV, p, L + 1, (bf16_t*)(p.ws + (((L + 1) & 1) ? WS_W1 : WS_W0)), q, sm);
        for (int i = bid * 512 + tid; i < MT * 64; i += nb * 512) { const int r = i >> 6, c4 = (i & 63) * 4;
            const float* src = (r < MPR) ? p.in[6] + ((size_t)L * MPR + r) * 256 + c4 : p.in[7] + ((size_t)L * 1024 + (r - MPR)) * 256 + c4; const f32x4 v = *(const f32x4*)src;
            uint2 w; w.x = pk2(v[0], v[1]); w.y = pk2(v[2], v[3]); *(uint2*)(pb + (size_t)r * 256 + c4) = w; }
        PH_END
        grid.sync();
        PH_BEGIN
        for (int it = bid; it < 1024; it += nb) gdn_partB(WV, p, L, proj, scr, br, it, sm);
        for (int it = bid; it < 1024; it += nb) gla_partB(WV, p, L, proj, scr, br, it, sm);
        PH_END
        grid.sync();
        PH_BEGIN { EpiProj E{gates, 4096, ss0, 1}; run_gemm(WV, shm, hb, wb + O_GATE, 4096, 1024, E); } PH_END
        grid.sync();
        PH_BEGIN
#pragma nounroll
        for (int g = 0; g < 4; ++g) { EpiMerge E{gates, mer, merged, g}; run_gemm(WV, shm, br + (size_t)g * MT * 256, wb + O_BR + (size_t)g * 1024 * 256, 1024, 256, E); }
        PH_END
        grid.sync();
        PH_BEGIN { EpiRes E{h, hb2, ss1}; run_gemm(WV, shm, merged, wb + O_O, 1024, 1024, E); } PH_END
        grid.sync();
        PH_BEGIN { EpiGU E{actb, ss1}; run_gemm(WV, shm, hb2, wb + O_GU, 5632, 1024, E); } PH_END
        grid.sync();
        PH_BEGIN { EpiRes E{h, hb, ss2}; run_gemm(WV, shm, actb, wb + O_DN, 1024, DFF, E); } PH_END
        PH_BEGIN { EpiF32 E{pe}; run_gemm(WV, shm, pb, wb + O_PLE, 1024, 256, E); } PH_END
        grid.sync();
        PH_BEGIN { EpiPG E{h, hb2, ss3, ss2, pe}; run_gemm(WV, shm, hb, wb + O_PG, 1024, 1024, E); } PH_END
        grid.sync();
    }
    { const int L = 0;
    PH_BEGIN const float* ssf = ss + (size_t)12 * MT * 16; const float* gf = p.in[32];
      for (int r = bid * 8 + wv; r < MT; r += nb * 8) { const float rstd = row_rstd(ssf, r);
#pragma unroll
          for (int j = 0; j < 4; ++j) { float* hp = h + (size_t)r * 1024 + j * 256 + lane * 4; const f32x4 v = *(const f32x4*)hp; const f32x4 gg = *(const f32x4*)(gf + j * 256 + lane * 4); *(f32x4*)hp = v * rstd * gg; } }
    PH_END }
}

extern "C" void kernel_launch(void* const* d_in, const int* in_sizes, int n_in, void* d_out, int out_size, void* d_ws, size_t ws_size, hipStream_t stream) {
    constexpr size_t kDynLds = 131072;
    static int grid_blocks = 0;
    if (!grid_blocks) {
        if (n_in != 33 || ws_size < WS_END) { fprintf(stderr, "kernel_launch: bad n_in %d or ws_size %zu < %zu\n", n_in, ws_size, (size_t)WS_END); grid_blocks = -1; return; }
        int dev = 0, cus = 0, per_cu = 0;
        hipGetDevice(&dev); hipDeviceGetAttribute(&cus, hipDeviceAttributeMultiprocessorCount, dev);
        hipFuncSetAttribute((const void*)mega, hipFuncAttributeMaxDynamicSharedMemorySize, (int)kDynLds);
        hipOccupancyMaxActiveBlocksPerMultiprocessor(&per_cu, (const void*)mega, 512, kDynLds);
        if (per_cu < 1) per_cu = 1;
        grid_blocks = cus * per_cu; if (grid_blocks > 256) grid_blocks = 256;
    }
    if (grid_blocks < 0) return;
    KP p{};
    for (int i = 0; i < 33; ++i) p.in[i] = (const float*)d_in[i];
    p.out = (float*)d_out; p.ws = (unsigned char*)d_ws;
    void* args[] = {&p};
    hipError_t e = hipLaunchCooperativeKernel((void*)mega, dim3(grid_blocks), dim3(512), args, kDynLds, stream);
    if (e != hipSuccess) fprintf(stderr, "cooperative launch failed: %s (grid %d)\n", hipGetErrorString(e), grid_blocks);
}
```

```cpp
#include <hip/hip_runtime.h>
#include <hip/hip_cooperative_groups.h>
#include <cstdio>
namespace cg = cooperative_groups;
#define CONV_C1 900
#define CONV_C2 3500
#ifndef REP_S2
#define REP_S2 1
#endif
#ifndef REP_S34
#define REP_S34 1
#endif
#ifndef REP_S1
#define REP_S1 1
#endif
#ifndef REP_S8
#define REP_S8 1
#endif
#ifndef REP_S5
#define REP_S5 1
#endif
#ifndef REP_S6
#define REP_S6 1
#endif
namespace pg8 {
#define PG8_LAS __attribute__((address_space(3)))
typedef unsigned short bf16_t;
typedef short bf16x8 __attribute__((ext_vector_type(8)));
typedef float f32x4 __attribute__((ext_vector_type(4)));
typedef unsigned u32x4 __attribute__((ext_vector_type(4)));
constexpr int BM = 256, BK = 64, HALF = 128, HTB = HALF * BK * 2  , STAGE_BYTES = 8 * HTB, NXCD = 8, WGM = 8;

__host__ __device__ __forceinline__ int lds_byte(int r, int c) { const int st = (r >> 4) * 2 + (c >> 5), rr = r & 15, cc = c & 31, ob = rr * 64 + cc * 2; return st * 1024 + (ob ^ (((ob >> 9) & 1) << 5)); }
__host__ __device__ __forceinline__ void stage_rc(int b, int& R, int& C) { const int st = b / 1024, sb = b % 1024, swz = sb ^ (((sb >> 9) & 1) << 5); R = (st >> 1) * 16 + swz / 64; C = (st & 1) * 32 + (swz % 64) / 2; }
__host__ __device__ __forceinline__ int perm32(int rho) { const int n = rho >> 4, i = rho & 15; return 8 * (i >> 2) + 4 * n + (i & 3); }

struct Unit { int pm, pn; };
struct Gemm { const bf16_t* A; const bf16_t* Bt; int M, N, K; };

struct StaticOrder {
    int nM, nN, nwg, G, c;
    __host__ __device__ void init(int M, int N, int G_, int c_) { nM = M / BM; nN = N / BM; nwg = nM * nN; G = G_; c = c_; }
    __host__ __device__ bool next(int i, Unit& u) const {
        const long L = (long)i * G + c; if (L >= nwg) return false;
        int wgid = (int)L; { const int q = nwg / NXCD, r = nwg % NXCD, xcd = wgid % NXCD, off = wgid / NXCD; wgid = (xcd < r ? xcd * (q + 1) : r * (q + 1) + (xcd - r) * q) + off; }
        const int nig = WGM * nN, gid = wgid / nig, fm = gid * WGM, gsz = (nM - fm) < WGM ? (nM - fm) : WGM;
        u.pm = fm + ((wgid % nig) % gsz); u.pn = (wgid % nig) / gsz; return true;
    }
    __device__ __forceinline__ void a_ready(const Unit&) const {}
    __device__ __forceinline__ void done(const Unit&) const {}
};
__device__ __forceinline__ unsigned cvt_pk_bf16(float lo, float hi) { unsigned r; asm volatile("v_cvt_pk_bf16_f32 %0, %1, %2" : "=v"(r) : "v"(lo), "v"(hi)); return r; }
template <class Epi, class Sched, bool STAMP = false>
__device__ __forceinline__ void gemm_phase(int WV, PG8_LAS unsigned char* lds, const Gemm g, const Sched& S, const Epi& E, unsigned long long* stamps) {
    int lid_; asm volatile("v_mbcnt_lo_u32_b32 %0, -1, 0\n\tv_mbcnt_hi_u32_b32 %0, -1, %0" : "=v"(lid_)); const int tid = WV * 64 + lid_, wid = WV, lane = tid & 63, wr = wid >> 2, wc = wid & 3, fr = lane & 15, fq = lane >> 4;
    const int K = g.K, nt = K / BK;
    int ts_lo = 0, ts_hi = 0, nts = 0; const unsigned long long rt_entry = STAMP ? (unsigned long long)wall_clock64() : 0ull;
#define PG8_STAMP() do { if (STAMP && wid == 0 && nts < 64) { const unsigned long long _c = (unsigned long long)clock64(); \
        ts_lo = (lane == nts) ? (int)(unsigned)_c : ts_lo; ts_hi = (lane == nts) ? (int)(unsigned)(_c >> 32) : ts_hi; ++nts; } } while (0)
    PG8_STAMP();
    unsigned voffA[2], voffB[2];
#pragma unroll
    for (int i = 0; i < 2; ++i) { int R, C; stage_rc(tid * 16 + i * 8192, R, C); const int Rb = Epi::PERM ? ((R & ~31) + perm32(R & 31)) : R;
        voffA[i] = (unsigned)(R * K + C) * 2u; voffB[i] = (unsigned)(Rb * K + C) * 2u; }
    const size_t kstep = (size_t)(BK * 2);
    const size_t hstep = (size_t)HALF * K * 2;
    const size_t tstep = 2 * hstep;
    const unsigned ldsw = (unsigned)wid * 1024u;
    const int aoff = lds_byte(wr * 64 + fr, fq * 8), boff = lds_byte(wc * 32 + fr, fq * 8);
#define PG8_SA(b, h) (((b) * 2 + (h)) * HTB)
#define PG8_SB(b, h) ((4 + (b) * 2 + (h)) * HTB)
#define PG8_STAGE(bufoff, gbase, voff) do { _Pragma("unroll") for (int _i = 0; _i < 2; ++_i) \
        __builtin_amdgcn_global_load_lds((const unsigned*)((const char*)(gbase) + (voff)[_i]), (PG8_LAS unsigned*)(lds + (bufoff) + ldsw + _i * 8192), 16, 0, 0); } while (0)
#define PG8_LDA(dst, b, h) do { _Pragma("unroll") for (int m = 0; m < 4; ++m) _Pragma("unroll") for (int k = 0; k < 2; ++k) dst[m][k] = *(const PG8_LAS bf16x8*)(lds + PG8_SA(b, h) + aoff + m * 2048 + k * 1024); } while (0)
#define PG8_LDB(dst, b, h) do { _Pragma("unroll") for (int n = 0; n < 2; ++n) _Pragma("unroll") for (int k = 0; k < 2; ++k) dst[n][k] = *(const PG8_LAS bf16x8*)(lds + PG8_SB(b, h) + boff + n * 2048 + k * 1024); } while (0)
#define PG8_MMA(ai, bj, At, Bt) do { __builtin_amdgcn_s_setprio(1); _Pragma("unroll") for (int m = 0; m < 4; ++m) _Pragma("unroll") for (int n = 0; n < 2; ++n) _Pragma("unroll") for (int k = 0; k < 2; ++k) \
        acc[ai][bj][m][n] = __builtin_amdgcn_mfma_f32_16x16x32_bf16(Bt[n][k], At[m][k], acc[ai][bj][m][n], 0, 0, 0); __builtin_amdgcn_s_setprio(0); } while (0)
#define PG8_WAIT_V(n) asm volatile("s_waitcnt vmcnt(" #n ")" ::: "memory")
#define PG8_WAIT_L(n) asm volatile("s_waitcnt lgkmcnt(" #n ")" ::: "memory")
#define PG8_BAR __builtin_amdgcn_s_barrier()
#define PG8_SCHED __builtin_amdgcn_sched_barrier(0)
    Unit cur, nxt; int ui = 0;
    if (!S.next(0, cur)) return;
    f32x4 acc[2][2][4][2];
#pragma unroll
    for (int a = 0; a < 2; ++a)
#pragma unroll
        for (int b = 0; b < 2; ++b)
#pragma unroll
            for (int m = 0; m < 4; ++m)
#pragma unroll
                for (int n = 0; n < 2; ++n) acc[a][b][m][n] = (f32x4){0.f, 0.f, 0.f, 0.f};
    if constexpr (Epi::HAS_INIT) E.init(acc, cur, wr, wc, fr, fq);
    bf16x8 At[4][2], B0[2][2], B1[2][2];
    const char* cA = (const char*)g.A + (size_t)cur.pm * tstep; const char* cB = (const char*)g.Bt + (size_t)cur.pn * tstep;
    S.a_ready(cur);
    PG8_STAGE(PG8_SB(0, 0), cB, voffB); PG8_STAGE(PG8_SA(0, 0), cA, voffA); PG8_STAGE(PG8_SB(0, 1), cB + hstep, voffB); PG8_STAGE(PG8_SA(0, 1), cA + hstep, voffA);
    if (wr == 1) PG8_BAR;
    PG8_WAIT_V(4); PG8_BAR;
    PG8_STAGE(PG8_SB(1, 0), cB + kstep, voffB); PG8_STAGE(PG8_SA(1, 0), cA + kstep, voffA); PG8_STAGE(PG8_SB(1, 1), cB + hstep + kstep, voffB);
    PG8_WAIT_V(6); PG8_BAR;
    PG8_STAMP();
    for (;;) {
        const bool has_next = S.next(ui + 1, nxt);
        const char* nA = has_next ? (const char*)g.A + (size_t)nxt.pm * tstep : cA; const char* nB = has_next ? (const char*)g.Bt + (size_t)nxt.pn * tstep : cB;
        for (int t = 0; t < nt; t += 2) {
            const bool last = (t == nt - 2);
            const char* a1 = cA + (size_t)(t + 1) * kstep;
            const char* a2 = last ? nA : cA + (size_t)(t + 2) * kstep; const char* b2 = last ? nB : cB + (size_t)(t + 2) * kstep;
            const char* a3 = a2 + kstep; const char* b3 = b2 + kstep;
            if (last && has_next) S.a_ready(nxt);
            PG8_LDB(B0, 0, 0); PG8_SCHED; PG8_LDA(At, 0, 0); PG8_STAGE(PG8_SA(1, 1), a1 + hstep, voffA);
            PG8_WAIT_L(8); PG8_BAR; PG8_WAIT_L(0); PG8_MMA(0, 0, At, B0); PG8_BAR; PG8_SCHED;
            PG8_LDB(B1, 0, 1); PG8_STAGE(PG8_SB(0, 0), b2, voffB);
            PG8_BAR; PG8_WAIT_L(0); PG8_MMA(0, 1, At, B1); PG8_BAR;
            PG8_LDA(At, 0, 1); PG8_STAGE(PG8_SA(0, 0), a2, voffA);
            PG8_BAR; PG8_WAIT_L(0); PG8_MMA(1, 0, At, B0); PG8_BAR; PG8_SCHED;
            PG8_STAGE(PG8_SB(0, 1), b2 + hstep, voffB);
            PG8_WAIT_V(6); PG8_BAR; PG8_MMA(1, 1, At, B1); PG8_BAR;
            PG8_LDB(B0, 1, 0); PG8_SCHED; PG8_LDA(At, 1, 0); PG8_STAGE(PG8_SA(0, 1), a2 + hstep, voffA);
            PG8_WAIT_L(8); PG8_BAR; PG8_WAIT_L(0); PG8_MMA(0, 0, At, B0); PG8_BAR; PG8_SCHED;
            PG8_LDB(B1, 1, 1); PG8_STAGE(PG8_SB(1, 0), b3, voffB);
            PG8_BAR; PG8_WAIT_L(0); PG8_MMA(0, 1, At, B1); PG8_BAR;
            PG8_LDA(At, 1, 1); PG8_STAGE(PG8_SA(1, 0), a3, voffA);
            PG8_BAR; PG8_WAIT_L(0); PG8_MMA(1, 0, At, B0); PG8_BAR; PG8_SCHED;
            PG8_STAGE(PG8_SB(1, 1), b3 + hstep, voffB);
            PG8_WAIT_V(6); PG8_BAR; PG8_MMA(1, 1, At, B1); PG8_BAR;
        }
        PG8_STAMP();
        if constexpr (!Epi::AFTER_DRAIN) { E(acc, cur, wr, wc, fr, fq); S.done(cur); }
        PG8_STAMP();
        if (!has_next) break;
#pragma unroll
        for (int a = 0; a < 2; ++a)
#pragma unroll
            for (int b = 0; b < 2; ++b)
#pragma unroll
                for (int m = 0; m < 4; ++m)
#pragma unroll
                    for (int n = 0; n < 2; ++n) acc[a][b][m][n] = (f32x4){0.f, 0.f, 0.f, 0.f};
        if constexpr (Epi::HAS_INIT) E.init(acc, nxt, wr, wc, fr, fq);
        cur = nxt; cA = nA; cB = nB; ++ui;
    }
    PG8_WAIT_V(0);
    if (wr == 0) PG8_BAR;
    PG8_BAR;
    if constexpr (Epi::AFTER_DRAIN) { E.fused(acc, cur, wr, wc, fr, fq, lds, wid, lane); S.done(cur); }
    PG8_STAMP();
    if (STAMP && wid == 0) { stamps[lane] = lane < nts ? (((unsigned long long)(unsigned)ts_hi << 32) | (unsigned)ts_lo) : 0ull;
        if (lane == 62) stamps[62] = rt_entry; if (lane == 63) stamps[63] = (unsigned long long)wall_clock64(); }
#undef PG8_STAMP
#undef PG8_SA
#undef PG8_SB
#undef PG8_STAGE
#undef PG8_LDA
#undef PG8_LDB
#undef PG8_MMA
#undef PG8_WAIT_V
#undef PG8_WAIT_L
#undef PG8_BAR
#undef PG8_SCHED
}
}

using pg8::bf16_t; using pg8::f32x4; using pg8::Unit;
constexpr int MT = 17408, MPR = 16384, NINP = 3328, DFF = 2816;
constexpr float EPSV = 1e-6f;
constexpr int C_GQ = 0, C_GK = 128, C_GV = 256, C_GR = 512, C_GA = 768, C_DQ = 784, C_DZ = 1552, C_DA = 1808, C_DB = 1812, C_CU = 1816, C_CV = 2072, C_SH = 2328, C_SB = 2584, C_SC = 2840;
constexpr size_t O_IN = 0, O_GATE = O_IN + (size_t)3328 * 1024, O_BR = O_GATE + (size_t)4096 * 1024, O_O = O_BR + (size_t)1024 * 1024, O_GU = O_O + (size_t)1024 * 1024,
                 O_DN = O_GU + (size_t)5632 * 1024, O_PG = O_DN + (size_t)1024 * 2816, O_PLE = O_PG + (size_t)1024 * 1024, W_ELEMS = O_PLE + (size_t)1024 * 256;
constexpr size_t WS_W0 = 0, WS_W1 = WS_W0 + W_ELEMS * 2, WS_PROJ = WS_W1 + W_ELEMS * 2, WS_GATES = WS_PROJ + (size_t)MT * NINP * 2, WS_HB = WS_GATES + (size_t)MT * 4096 * 2,
                 WS_HB2 = WS_HB + (size_t)MT * 1024 * 2, WS_BR = WS_HB2 + (size_t)MT * 1024 * 2, WS_PB = WS_BR + (size_t)MT * 1024 * 2, WS_SS = WS_PB + (size_t)MT * 256 * 2, WS_BAR = WS_SS + (size_t)13 * MT * 16 * 4, WS_END = WS_BAR + 16384;
constexpr size_t PR_MER = 0, PR_MERGED = (size_t)MT * 1024 * 4;
constexpr size_t SC_GT = 0, SC_GR = SC_GT + (size_t)1024 * 4096, SC_GQ = SC_GR + (size_t)1024 * 4096, SC_GO = SC_GQ + (size_t)1024 * 4096, SC_GS = SC_GO + (size_t)1024 * 4096,
                 SC_ADS = SC_GS + (size_t)1024 * 4096, SC_AS = SC_ADS + (size_t)1024 * 2048, SC_ADEC = SC_AS + (size_t)1024 * 2048;
constexpr size_t OUT_GLAP = 17825792, OUT_GLAS = 18087936, OUT_GDNP = 22282240, OUT_GDNS = 22806528, OUT_GCP = 31195136, OUT_GCS = 31268864, OUT_SCP = 32448512, OUT_SCS = 32464896, OUT_CVS = 32727040;

struct KP { const float* in[33]; float* out; unsigned char* ws; };

__device__ __forceinline__ float bf2f(bf16_t b) { return __uint_as_float(((unsigned)b) << 16); }
__device__ __forceinline__ unsigned pk2(float lo, float hi) { return pg8::cvt_pk_bf16(lo, hi); }
__device__ __forceinline__ void unpack4(uint2 v, float* o) { o[0] = __uint_as_float(v.x << 16); o[1] = __uint_as_float(v.x & 0xffff0000u); o[2] = __uint_as_float(v.y << 16); o[3] = __uint_as_float(v.y & 0xffff0000u); }
__device__ __forceinline__ float sigm(float x) { return __builtin_amdgcn_rcpf(1.f + __builtin_amdgcn_exp2f(-1.4426950408889634f * x)); }
__device__ __forceinline__ float siluf_(float x) { return x * sigm(x); }
__device__ __forceinline__ float softplusf_(float x) { return x > 20.f ? x : log1pf(__expf(x)); }
__device__ __forceinline__ float logsigm(float x) { return fminf(x, 0.f) - log1pf(__expf(-fabsf(x))); }
__device__ __forceinline__ float geluf_(float x) { const float y = 0.7978845608f * (x + 0.044715f * x * x * x); return x * (1.f - __builtin_amdgcn_rcpf(1.f + __builtin_amdgcn_exp2f(2.8853900817779268f * y))); }
template <int M> __device__ __forceinline__ float swz(float v) { return __int_as_float(__builtin_amdgcn_ds_swizzle(__float_as_int(v), (M << 10) | 0x1f)); }
__device__ __forceinline__ float bperm(int srclane, float v) { return __int_as_float(__builtin_amdgcn_ds_bpermute(srclane << 2, __float_as_int(v))); }
__device__ __forceinline__ float wave_sum(float v) {
    v += swz<1>(v); v += swz<2>(v); v += swz<4>(v); v += swz<8>(v); v += swz<16>(v);
    return __int_as_float(__builtin_amdgcn_readlane(__float_as_int(v), 0)) + __int_as_float(__builtin_amdgcn_readlane(__float_as_int(v), 32));
}
__device__ __forceinline__ int otid(int WV) { int t; asm volatile("v_mbcnt_lo_u32_b32 %0, -1, 0\n\tv_mbcnt_hi_u32_b32 %0, -1, %0" : "=v"(t)); return WV * 64 + t; }
__device__ __forceinline__ int obid() { int t = blockIdx.x; asm volatile("" : "+s"(t)); return t; }
__device__ __forceinline__ float rdl(float v, int l) { return __int_as_float(__builtin_amdgcn_readlane(__float_as_int(v), l)); }

__device__ __forceinline__ float row_rstd(const float* ssp, int r) { const f32x4* q = (const f32x4*)(ssp + (size_t)r * 16); const f32x4 a = q[0], b = q[1], c = q[2], d = q[3];
    const float s = (((a[0] + a[1]) + (a[2] + a[3])) + ((b[0] + b[1]) + (b[2] + b[3]))) + (((c[0] + c[1]) + (c[2] + c[3])) + ((d[0] + d[1]) + (d[2] + d[3]))); return rsqrtf(s * (1.f / 1024.f) + EPSV); }
#define EPI_ROWS _Pragma("unroll") for (int ai = 0; ai < 2; ++ai) _Pragma("unroll") for (int m = 0; m < 4; ++m)
#define EPI_COLS _Pragma("unroll") for (int bj = 0; bj < 2; ++bj) _Pragma("unroll") for (int n = 0; n < 2; ++n)
#define EPI_R (u.pm * 256 + ai * 128 + wr * 64 + m * 16 + fr)
#define EPI_C (u.pn * 256 + bj * 128 + wc * 32 + n * 16 + 4 * fq)
#define EPI_RSTD8(rs, ssp) const PG8_LAS float* rs = tab + ne * 256 + wr * 64 + fr; ++ne;
#define RS_AT(rs, ssp, ai, m, r) rs[(ai) * 128 + (m) * 16]
struct EpiProj {
    static constexpr bool PERM = true, AFTER_DRAIN = false, HAS_INIT = false;
    bf16_t* O; int ldo; const PG8_LAS float* tab; mutable int ne;
    __device__ __forceinline__ void operator()(const f32x4 (&acc)[2][2][4][2], const Unit& u, int wr, int wc, int fr, int fq) const {
        EPI_RSTD8(rs, ss)
        EPI_ROWS { const int r = EPI_R; const float rstd = RS_AT(rs, ss, ai, m, r);
#pragma unroll
            for (int bj = 0; bj < 2; ++bj) { const int c = u.pn * 256 + bj * 128 + wc * 32 + 8 * fq; const f32x4 v0 = acc[ai][bj][m][0] * rstd, v1 = acc[ai][bj][m][1] * rstd;
                pg8::u32x4 w; w.x = pk2(v0[0], v0[1]); w.y = pk2(v0[2], v0[3]); w.z = pk2(v1[0], v1[1]); w.w = pk2(v1[2], v1[3]); *(pg8::u32x4*)(O + (size_t)r * ldo + c) = w; } }
    }
};
struct EpiP {
    static constexpr bool PERM = true, AFTER_DRAIN = false, HAS_INIT = false;
    bf16_t* P;
    __device__ __forceinline__ void operator()(const f32x4 (&acc)[2][2][4][2], const Unit& u, int wr, int wc, int fr, int fq) const {
        const int g = u.pn >> 2, pm = u.pm - g * 68, pn = u.pn & 3;
        EPI_ROWS { const int r = pm * 256 + ai * 128 + wr * 64 + m * 16 + fr;
#pragma unroll
            for (int bj = 0; bj < 2; ++bj) { const int c = pn * 256 + bj * 128 + wc * 32 + 8 * fq; const f32x4 v0 = acc[ai][bj][m][0], v1 = acc[ai][bj][m][1];
                pg8::u32x4 w; w.x = pk2(v0[0], v0[1]); w.y = pk2(v0[2], v0[3]); w.z = pk2(v1[0], v1[1]); w.w = pk2(v1[2], v1[3]); *(pg8::u32x4*)(P + (size_t)r * 4096 + g * 1024 + c) = w; } }
    }
};
struct EpiGateMerge {
    static constexpr bool PERM = true, AFTER_DRAIN = false, HAS_INIT = false;
    const bf16_t* P; bf16_t* merged; const PG8_LAS float* tab; mutable int ne;
    __device__ __forceinline__ void operator()(const f32x4 (&acc)[2][2][4][2], const Unit& u, int wr, int wc, int fr, int fq) const {
        EPI_RSTD8(rs, ss)
        const int d0 = u.pn * 64 + wc * 16 + 4 * fq;
        uint2 pc[4], pnx[4];
        { const int r = u.pm * 256 + wr * 64 + fr;
#pragma unroll
          for (int g = 0; g < 4; ++g) pc[g] = *(const uint2*)(P + (size_t)r * 4096 + g * 1024 + d0); }
#pragma unroll
        for (int q8 = 0; q8 < 8; ++q8) { const int ai = q8 >> 2, m = q8 & 3; const int r = EPI_R; const float rstd = RS_AT(rs, ss, ai, m, r);
            if (q8 < 7) { const int ai2 = (q8 + 1) >> 2, m2 = (q8 + 1) & 3; const int r2 = u.pm * 256 + ai2 * 128 + wr * 64 + m2 * 16 + fr;
#pragma unroll
                for (int g = 0; g < 4; ++g) pnx[g] = *(const uint2*)(P + (size_t)r2 * 4096 + g * 1024 + d0); }
            f32x4 sum = (f32x4){0.f, 0.f, 0.f, 0.f};
#pragma unroll
            for (int g = 0; g < 4; ++g) { float pv[4]; unpack4(pc[g], pv); const f32x4 a = acc[ai][g >> 1][m][g & 1] * rstd;
                sum[0] += sigm(a[0]) * pv[0]; sum[1] += sigm(a[1]) * pv[1]; sum[2] += sigm(a[2]) * pv[2]; sum[3] += sigm(a[3]) * pv[3]; }
            uint2 w; w.x = pk2(sum[0], sum[1]); w.y = pk2(sum[2], sum[3]); *(uint2*)(merged + (size_t)r * 1024 + d0) = w;
#pragma unroll
            for (int g = 0; g < 4; ++g) pc[g] = pnx[g]; }
    }
};
struct EpiRes {
    static constexpr bool PERM = false, AFTER_DRAIN = false, HAS_INIT = true;
    const bf16_t* hin; bf16_t* hout; float* ssn;
    __device__ __forceinline__ void init(f32x4 (&acc)[2][2][4][2], const Unit& u, int wr, int wc, int fr, int fq) const {
        EPI_ROWS { const int r = EPI_R; EPI_COLS { const int c = EPI_C; float f[4]; unpack4(*(const uint2*)(hin + (size_t)r * 1024 + c), f); acc[ai][bj][m][n] = (f32x4){f[0], f[1], f[2], f[3]}; } }
    }
    __device__ __forceinline__ void operator()(const f32x4 (&acc)[2][2][4][2], const Unit& u, int wr, int wc, int fr, int fq) const {
        EPI_ROWS { const int r = EPI_R; float s = 0.f;
            EPI_COLS { const int c = EPI_C; const f32x4 v = acc[ai][bj][m][n];
                uint2 w; w.x = pk2(v[0], v[1]); w.y = pk2(v[2], v[3]); *(uint2*)(hout + (size_t)r * 1024 + c) = w;
                s += (v[0] * v[0] + v[1] * v[1]) + (v[2] * v[2] + v[3] * v[3]); }
            s += swz<16>(s); s += bperm((fq * 16 + fr) ^ 32, s);
            if (fq == 0) ssn[(size_t)r * 16 + u.pn * 4 + wc] = s; }
    }
};
struct EpiGU {
    static constexpr bool PERM = true, AFTER_DRAIN = false, HAS_INIT = false;
    bf16_t* O; const PG8_LAS float* tab; mutable int ne;
    __device__ __forceinline__ void operator()(const f32x4 (&acc)[2][2][4][2], const Unit& u, int wr, int wc, int fr, int fq) const {
        EPI_RSTD8(rs, ss)
        EPI_ROWS { const int r = EPI_R; const float rstd = RS_AT(rs, ss, ai, m, r); const int c = u.pn * 128 + wc * 32 + 8 * fq;
            const f32x4 g0 = acc[ai][0][m][0] * rstd, g1 = acc[ai][0][m][1] * rstd, u0 = acc[ai][1][m][0] * rstd, u1 = acc[ai][1][m][1] * rstd;
            pg8::u32x4 w; w.x = pk2(siluf_(g0[0]) * u0[0], siluf_(g0[1]) * u0[1]); w.y = pk2(siluf_(g0[2]) * u0[2], siluf_(g0[3]) * u0[3]);
            w.z = pk2(siluf_(g1[0]) * u1[0], siluf_(g1[1]) * u1[1]); w.w = pk2(siluf_(g1[2]) * u1[2], siluf_(g1[3]) * u1[3]);
            *(pg8::u32x4*)(O + (size_t)r * DFF + c) = w; }
    }
};
struct EpiF32 {
    static constexpr bool PERM = false, AFTER_DRAIN = false, HAS_INIT = false;
    float* C;
    __device__ __forceinline__ void operator()(const f32x4 (&acc)[2][2][4][2], const Unit& u, int wr, int wc, int fr, int fq) const {
        EPI_ROWS { const int r = EPI_R; EPI_COLS { const int c = EPI_C; *(f32x4*)(C + (size_t)r * 1024 + c) = acc[ai][bj][m][n]; } }
    }
};
struct EpiPG {
    static constexpr bool PERM = false, AFTER_DRAIN = false, HAS_INIT = false;
    const bf16_t* hin; bf16_t* hout; float* ssn; const float* pe; const PG8_LAS float* tab; mutable int ne;
    __device__ __forceinline__ void operator()(const f32x4 (&acc)[2][2][4][2], const Unit& u, int wr, int wc, int fr, int fq) const {
        EPI_RSTD8(rs, ss)
        uint2 hc[4], hn[4]; f32x4 qc[4], qn[4];
        { const int r = u.pm * 256 + wr * 64 + fr;
#pragma unroll
          for (int q = 0; q < 4; ++q) { const size_t o = (size_t)r * 1024 + u.pn * 256 + (q >> 1) * 128 + wc * 32 + (q & 1) * 16 + 4 * fq; hc[q] = *(const uint2*)(hin + o); qc[q] = *(const f32x4*)(pe + o); } }
#pragma unroll
        for (int q8 = 0; q8 < 8; ++q8) { const int ai = q8 >> 2, m = q8 & 3; const int r = EPI_R; const float rstd = RS_AT(rs, ss, ai, m, r); float s = 0.f;
            if (q8 < 7) { const int ai2 = (q8 + 1) >> 2, m2 = (q8 + 1) & 3; const int r2 = u.pm * 256 + ai2 * 128 + wr * 64 + m2 * 16 + fr;
#pragma unroll
                for (int q = 0; q < 4; ++q) { const size_t o = (size_t)r2 * 1024 + u.pn * 256 + (q >> 1) * 128 + wc * 32 + (q & 1) * 16 + 4 * fq; hn[q] = *(const uint2*)(hin + o); qn[q] = *(const f32x4*)(pe + o); } }
            EPI_COLS { const int c = EPI_C; const f32x4 a = acc[ai][bj][m][n] * rstd; const f32x4 pv = qc[bj * 2 + n]; float v[4]; unpack4(hc[bj * 2 + n], v);
                v[0] += sigm(a[0]) * pv[0]; v[1] += sigm(a[1]) * pv[1]; v[2] += sigm(a[2]) * pv[2]; v[3] += sigm(a[3]) * pv[3];
                uint2 w; w.x = pk2(v[0], v[1]); w.y = pk2(v[2], v[3]); *(uint2*)(hout + (size_t)r * 1024 + c) = w;
                s += (v[0] * v[0] + v[1] * v[1]) + (v[2] * v[2] + v[3] * v[3]); }
            s += swz<16>(s); s += bperm((fq * 16 + fr) ^ 32, s);
            if (fq == 0) ssn[(size_t)r * 16 + u.pn * 4 + wc] = s;
#pragma unroll
            for (int q = 0; q < 4; ++q) { hc[q] = hn[q]; qc[q] = qn[q]; } }
    }
};
struct TailOrder : pg8::StaticOrder {
    int skip;
    __device__ __forceinline__ bool next(int i, Unit& u) const { if (c < skip) return false; pg8::StaticOrder t = *this; t.G = G - skip; t.c = c - skip; return t.next(i, u); }
};
struct GroupOrder {
    int G, c;
    __device__ __forceinline__ bool next(int i, Unit& u) const { const int L = i * G + c; if (L >= 4 * 272) return false; const int g = L / 272, r = L - g * 272; u.pm = g * 68 + (r >> 2); u.pn = g * 4 + (r & 3); return true; }
    __device__ __forceinline__ void a_ready(const Unit&) const {}
    __device__ __forceinline__ void done(const Unit&) const {}
};
template <class Epi> __device__ __forceinline__ void run_gemm(int WV, unsigned char* shm, const bf16_t* A, const bf16_t* Bt, int N, int K, const Epi& E) {
    pg8::StaticOrder S; S.init(MT, N, (int)gridDim.x, obid());
    pg8::Gemm g{A, Bt, MT, N, K};
#ifndef NO_GEMM
    pg8::gemm_phase<Epi, pg8::StaticOrder, false>(WV, (PG8_LAS unsigned char*)shm, g, S, E, nullptr);
#endif
}

#define RS_TAB(shm) ((PG8_LAS float*)((PG8_LAS unsigned char*)(shm) + 131072))
template <class Epi> __device__ __forceinline__ void run_gemm_rs(int WV, unsigned char* shm, const bf16_t* A, const bf16_t* Bt, int N, int K, const Epi& E, const float* ssp) {
    pg8::StaticOrder S; S.init(MT, N, (int)gridDim.x, obid());
    { const int tid = otid(WV); Unit u; PG8_LAS float* tab = RS_TAB(shm);
      if (tid < 256) for (int i = 0; i < 8 && S.next(i, u); ++i) tab[i * 256 + tid] = row_rstd(ssp, u.pm * 256 + tid);
      __syncthreads(); }
    pg8::Gemm g{A, Bt, MT, N, K};
    pg8::gemm_phase<Epi, pg8::StaticOrder, false>(WV, (PG8_LAS unsigned char*)shm, g, S, E, nullptr);
}
__device__ __forceinline__ void conv_tile(int WV, const float* src, int ldsrc, int K, int Nvalid, const float* gain, bf16_t* dst, int blk, int blkstride, int off, int kt, int ntile, float* sm) {
    const int tid = otid(WV), k0 = kt * 64, n0 = ntile * 64;
#pragma unroll
    for (int i = 0; i < 8; ++i) { const int idx = tid + 512 * i, kk = idx >> 6, jj = idx & 63, j = n0 + jj; float v = 0.f;
        if (j < Nvalid) { v = src[(size_t)(k0 + kk) * ldsrc + j]; if (gain) v *= gain[k0 + kk]; }
        sm[kk * 65 + jj] = v; }
    __syncthreads();
#pragma unroll
    for (int i = 0; i < 4; ++i) { const int idx = tid + 512 * i, jj = idx >> 5, kp = idx & 31, j = n0 + jj; const int drow = (blk < 0) ? (((j & 1023) >> 6) * 256 + 128 * (j >> 11) + 32 * ((j & 63) >> 4) + 8 * ((j >> 2) & 3) + 4 * ((j >> 10) & 1) + (j & 3)) : ((j / blk) * blkstride + off + (j % blk));
        *(unsigned*)(dst + (size_t)drow * K + k0 + 2 * kp) = pk2(sm[(2 * kp) * 65 + jj], sm[(2 * kp + 1) * 65 + jj]); }
    __syncthreads();
}
constexpr int NCONV = 4800;
__device__ __forceinline__ void conv_job(int WV, const KP& p, int L, bf16_t* wb, int q, float* sm) {
    const float* src; int ld, K, Nv, blk = 1 << 30, bs = 0, off = 0, kt, nt; const float* gain = nullptr; bf16_t* dst;
    if (q < 832) { kt = q / 52; nt = q % 52; src = p.in[9] + (size_t)L * 1024 * 3096; ld = 3096; K = 1024; Nv = 3096; gain = p.in[8] + L * 1024; dst = wb + O_IN; }
    else if ((q -= 832) < 1024) { kt = q / 64; nt = q % 64; src = p.in[22] + (size_t)L * 1024 * 4096; ld = 4096; K = 1024; Nv = 4096; gain = p.in[8] + L * 1024; dst = wb + O_GATE; blk = -1; }
    else if ((q -= 1024) < 256) { const int g = q >> 6, r = q & 63; kt = r >> 4; nt = r & 15; src = p.in[23] + (size_t)(L * 4 + g) * 256 * 1024; ld = 1024; K = 256; Nv = 1024; dst = wb + O_BR + (size_t)g * 1024 * 256; }
    else if ((q -= 256) < 256) { kt = q >> 4; nt = q & 15; src = p.in[24] + (size_t)L * 1024 * 1024; ld = 1024; K = 1024; Nv = 1024; dst = wb + O_O; }
    else if ((q -= 256) < 704) { kt = q / 44; nt = q % 44; src = p.in[26] + (size_t)L * 1024 * DFF; ld = DFF; K = 1024; Nv = DFF; gain = p.in[25] + L * 1024; dst = wb + O_GU; blk = 128; bs = 256; off = 0; }
    else if ((q -= 704) < 704) { kt = q / 44; nt = q % 44; src = p.in[27] + (size_t)L * 1024 * DFF; ld = DFF; K = 1024; Nv = DFF; gain = p.in[25] + L * 1024; dst = wb + O_GU; blk = 128; bs = 256; off = 128; }
    else if ((q -= 704) < 704) { kt = q >> 4; nt = q & 15; src = p.in[28] + (size_t)L * DFF * 1024; ld = 1024; K = DFF; Nv = 1024; dst = wb + O_DN; }
    else if ((q -= 704) < 256) { kt = q >> 4; nt = q & 15; src = p.in[30] + (size_t)L * 1024 * 1024; ld = 1024; K = 1024; Nv = 1024; gain = p.in[29] + L * 1024; dst = wb + O_PG; }
    else { q -= 256; kt = q >> 4; nt = q & 15; src = p.in[31] + (size_t)L * 256 * 1024; ld = 1024; K = 256; Nv = 1024; dst = wb + O_PLE; }
    conv_tile(WV, src, ld, K, Nv, gain, dst, blk, bs, off, kt, nt, sm);
}
struct CJ { const float* src; const float* gain; bf16_t* dst; int ld, K, Nv, blk, bs, off, kt, nt; };
__device__ __forceinline__ CJ conv_args(const KP& p, int L, bf16_t* wb, int q) {
    const float* src; int ld, K, Nv, blk = 1 << 30, bs = 0, off = 0, kt, nt; const float* gain = nullptr; bf16_t* dst;
    if (q < 832) { kt = q / 52; nt = q % 52; src = p.in[9] + (size_t)L * 1024 * 3096; ld = 3096; K = 1024; Nv = 3096; gain = p.in[8] + L * 1024; dst = wb + O_IN; }
    else if ((q -= 832) < 1024) { kt = q / 64; nt = q % 64; src = p.in[22] + (size_t)L * 1024 * 4096; ld = 4096; K = 1024; Nv = 4096; gain = p.in[8] + L * 1024; dst = wb + O_GATE; blk = -1; }
    else if ((q -= 1024) < 256) { const int g = q >> 6, r = q & 63; kt = r >> 4; nt = r & 15; src = p.in[23] + (size_t)(L * 4 + g) * 256 * 1024; ld = 1024; K = 256; Nv = 1024; dst = wb + O_BR + (size_t)g * 1024 * 256; }
    else if ((q -= 256) < 256) { kt = q >> 4; nt = q & 15; src = p.in[24] + (size_t)L * 1024 * 1024; ld = 1024; K = 1024; Nv = 1024; dst = wb + O_O; }
    else if ((q -= 256) < 704) { kt = q / 44; nt = q % 44; src = p.in[26] + (size_t)L * 1024 * DFF; ld = DFF; K = 1024; Nv = DFF; gain = p.in[25] + L * 1024; dst = wb + O_GU; blk = 128; bs = 256; off = 0; }
    else if ((q -= 704) < 704) { kt = q / 44; nt = q % 44; src = p.in[27] + (size_t)L * 1024 * DFF; ld = DFF; K = 1024; Nv = DFF; gain = p.in[25] + L * 1024; dst = wb + O_GU; blk = 128; bs = 256; off = 128; }
    else if ((q -= 704) < 704) { kt = q >> 4; nt = q & 15; src = p.in[28] + (size_t)L * DFF * 1024; ld = 1024; K = DFF; Nv = 1024; dst = wb + O_DN; }
    else if ((q -= 704) < 256) { kt = q >> 4; nt = q & 15; src = p.in[30] + (size_t)L * 1024 * 1024; ld = 1024; K = 1024; Nv = 1024; gain = p.in[29] + L * 1024; dst = wb + O_PG; }
    else { q -= 256; kt = q >> 4; nt = q & 15; src = p.in[31] + (size_t)L * 256 * 1024; ld = 1024; K = 256; Nv = 1024; dst = wb + O_PLE; }
    CJ c; c.src = src; c.gain = gain; c.dst = dst; c.ld = ld; c.K = K; c.Nv = Nv; c.blk = blk; c.bs = bs; c.off = off; c.kt = kt; c.nt = nt; return c;
}

#define LBAR() do { asm volatile("s_waitcnt lgkmcnt(0)" ::: "memory"); __builtin_amdgcn_s_barrier(); asm volatile("" ::: "memory"); } while (0)
__device__ __forceinline__ void conv_load(const CJ& c, int tid, float (&v)[8]) {
    const int k0 = c.kt * 64, n0 = c.nt * 64;
#pragma unroll
    for (int i = 0; i < 8; ++i) { const int idx = tid + 512 * i, kk = idx >> 6, jj = idx & 63, j = n0 + jj; float x = 0.f;
        if (j < c.Nv) { x = c.src[(size_t)(k0 + kk) * c.ld + j]; if (c.gain) x *= c.gain[k0 + kk]; }
        v[i] = x; }
}
__device__ __forceinline__ void conv_store(const CJ& c, int tid, const float (&v)[8], float* sm) {
    const int k0 = c.kt * 64, n0 = c.nt * 64;
#pragma unroll
    for (int i = 0; i < 8; ++i) { const int idx = tid + 512 * i, kk = idx >> 6, jj = idx & 63; sm[kk * 65 + jj] = v[i]; }
    LBAR();
#pragma unroll
    for (int i = 0; i < 4; ++i) { const int idx = tid + 512 * i, jj = idx >> 5, kp = idx & 31, j = n0 + jj;
        const int drow = (c.blk < 0) ? (((j & 1023) >> 6) * 256 + 128 * (j >> 11) + 32 * ((j & 63) >> 4) + 8 * ((j >> 2) & 3) + 4 * ((j >> 10) & 1) + (j & 3)) : ((j / c.blk) * c.bs + c.off + (j % c.blk));
        *(unsigned*)(c.dst + (size_t)drow * c.K + k0 + 2 * kp) = pk2(sm[(2 * kp) * 65 + jj], sm[(2 * kp + 1) * 65 + jj]); }
    LBAR();
}
__device__ __forceinline__ void conv_stream(int WV, const KP& p, int L, bf16_t* wb, int q0, int stride, float* sm) {
    const int tid = otid(WV);
    if (q0 >= NCONV) return;
    CJ c = conv_args(p, L, wb, q0); float v[8]; conv_load(c, tid, v);
    for (int q = q0;;) { const int qn = q + stride; const bool has = qn < NCONV; CJ cn = c; float vn[8];
        if (has) { cn = conv_args(p, L, wb, qn); conv_load(cn, tid, vn); }
        conv_store(c, tid, v, sm);
        if (!has) break;
        c = cn; q = qn;
#pragma unroll
        for (int i = 0; i < 8; ++i) v[i] = vn[i]; }
}

typedef float f32x16 __attribute__((ext_vector_type(16)));
template <int K> __device__ __forceinline__ void mm32(f32x16& acc, const float* a, int sai, int sak, const float* b, int sbk, int sbj, int lane) {
    const int l31 = lane & 31, hi = lane >> 5;
    const float* ap = a + l31 * sai + hi * sak; const float* bp = b + hi * sbk + l31 * sbj;
#pragma unroll 8
    for (int k = 0; k < K; k += 2) acc = __builtin_amdgcn_mfma_f32_32x32x2f32(ap[k * sak], bp[k * sbk], acc, 0, 0, 0);
}
#define MM_ROW(r, lane) (((r) & 3) + 8 * ((r) >> 2) + 4 * ((lane) >> 5))
struct MX { const KP* p; int L; const bf16_t* proj; float* scr; bf16_t* br; };

__device__ __forceinline__ void gdn_partA(int WV, const KP& p, int L, const bf16_t* proj, float* scr, int item, float* sm) {
    const int tid = otid(WV), lane = tid & 63, wv = tid >> 6;
    const int h = item & 3, n = (item >> 2) & 31, b = item >> 7, t0 = b * 2048 + n * 64;
    float* sq = sm; float* sk = sq + 64 * 65; float* sv = sk + 64 * 65; float* sMm = sv + 64 * 65; float* sQK = sMm + 64 * 68; float* sX = sQK + 64 * 65; float* sG = sX + 64 * 129; float* sB = sG + 64;
    const float* cw = p.in[13] + (size_t)L * 4 * 768;
    if (tid < 384) {
        const int cq = tid % 48, rg = tid / 48, part = cq >> 4, ch0 = (cq & 15) * 4, col = part * 256 + h * 64 + ch0;
        uint2 raw[11];
#pragma unroll
        for (int i = 0; i < 11; ++i) { const int tt = n * 64 + rg * 8 - 3 + i; raw[i] = (tt >= 0) ? *(const uint2*)(proj + (size_t)(b * 2048 + tt) * NINP + C_DQ + col) : make_uint2(0u, 0u); }
        f32x4 wj[4];
#pragma unroll
        for (int j = 0; j < 4; ++j) wj[j] = *(const f32x4*)(cw + j * 768 + col);
        float xr[11][4];
#pragma unroll
        for (int i = 0; i < 11; ++i) unpack4(raw[i], xr[i]);
        float* dstp = (part == 0 ? sq : (part == 1 ? sk : sv));
#pragma unroll
        for (int i = 0; i < 8; ++i) {
#pragma unroll
            for (int c = 0; c < 4; ++c) { const float y = wj[0][c] * xr[i][c] + wj[1][c] * xr[i + 1][c] + wj[2][c] * xr[i + 2][c] + wj[3][c] * xr[i + 3][c]; dstp[(rg * 8 + i) * 65 + ch0 + c] = siluf_(y); } }
    }
    if (n == 31) for (int idx = tid; idx < 3 * 192; idx += 512) { const int j = idx / 192, cc = idx - j * 192, col = (cc >> 6) * 256 + h * 64 + (cc & 63);
        p.out[OUT_GCP + ((size_t)(L * 8 + b) * 3 + j) * 768 + col] = bf2f(proj[(size_t)(b * 2048 + 2045 + j) * NINP + C_DQ + col]); }
    if (tid < 64) {
        const float a = bf2f(proj[(size_t)(t0 + tid) * NINP + C_DA + h]), bb = bf2f(proj[(size_t)(t0 + tid) * NINP + C_DB + h]);
        float g = -__expf(p.in[14][L * 4 + h]) * softplusf_(a + p.in[15][L * 4 + h]);
        sB[tid] = sigm(bb);
#pragma unroll
        for (int o = 1; o < 64; o <<= 1) { const float t = bperm(tid - o, g); if (tid >= o) g += t; }
        sG[tid] = g;
    }
    __syncthreads();
    for (int i = 0; i < 8; ++i) { const int l = wv * 8 + i; const float x = sq[l * 65 + lane]; float s = wave_sum(x * x); sq[l * 65 + lane] = x * rsqrtf(s + EPSV) * 0.125f;
        const float y = sk[l * 65 + lane]; s = wave_sum(y * y); sk[l * 65 + lane] = y * rsqrtf(s + EPSV); }
    __syncthreads();
    {
        const int pr = wv >> 2, qd = wv & 3, qi = (qd >> 1) * 32, qj = (qd & 1) * 32;
        f32x16 acc;
#pragma unroll
        for (int r = 0; r < 16; ++r) acc[r] = 0.f;
        if (qd != 1) mm32<64>(acc, (pr == 0 ? sk : sq) + qi * 65, 65, 1, sk + qj * 65, 1, 65, lane);
        float* dstm = (pr == 0) ? sMm : sQK;
#pragma unroll
        for (int r = 0; r < 16; ++r) { const int i = qi + MM_ROW(r, lane), j = qj + (lane & 31); const float dec = (j <= i) ? __expf(sG[i] - sG[j]) : 0.f;
            dstm[i * ((pr == 0) ? 68 : 65) + j] = (pr == 0) ? ((j < i) ? sB[i] * dec * acc[r] : 0.f) : dec * acc[r]; }
        for (int idx = tid; idx < 64 * 128; idx += 512) { const int l = idx >> 7, col = idx & 127;
            sX[l * 129 + col] = (col < 64) ? sB[l] * sv[l * 65 + col] : sB[l] * __expf(sG[l]) * sk[l * 65 + col - 64]; }
    }
    __syncthreads();
    for (int I = 0; I < 4; ++I) { const int r0 = I * 16, r1 = r0 + 16;
        if (tid < 128) { float x[16];
#pragma unroll
            for (int l = 0; l < 16; ++l) x[l] = sX[(r0 + l) * 129 + tid];
#pragma unroll
            for (int l = 1; l < 16; ++l) {
#pragma unroll
                for (int mm = 0; mm < l; ++mm) x[l] -= sMm[(r0 + l) * 68 + r0 + mm] * x[mm]; }
#pragma unroll
            for (int l = 1; l < 16; ++l) sX[(r0 + l) * 129 + tid] = x[l]; }
        __syncthreads();
        if (r1 < 64) { const int col = tid & 127, rg = tid >> 7; float xb[16];
#pragma unroll
            for (int mm = 0; mm < 16; ++mm) xb[mm] = sX[(r0 + mm) * 129 + col];
            for (int r = r1 + rg; r < 64; r += 4) { float acc = sX[r * 129 + col]; const f32x4* mp = (const f32x4*)(sMm + r * 68 + r0);
#pragma unroll
                for (int q = 0; q < 4; ++q) { const f32x4 m4 = mp[q]; acc -= m4[0] * xb[4 * q] + m4[1] * xb[4 * q + 1] + m4[2] * xb[4 * q + 2] + m4[3] * xb[4 * q + 3]; }
                sX[r * 129 + col] = acc; } }
        __syncthreads();
    }
    const float g63 = sG[63];
    for (int idx = tid; idx < 64 * 64; idx += 512) { const int l = idx >> 6, c = idx & 63; sk[l * 65 + c] *= __expf(g63 - sG[l]); }
    __syncthreads();
    {
        const float dn = __expf(g63);
#pragma unroll
        for (int jj = 0; jj < 2; ++jj) { const int jb = wv + 8 * jj, pr = jb >> 2, qd = jb & 3, qi = (qd >> 1) * 32, qj = (qd & 1) * 32;
            f32x16 acc;
#pragma unroll
            for (int r = 0; r < 16; ++r) acc[r] = 0.f;
            if (pr < 2) mm32<64>(acc, sk + qi, 1, 65, sX + ((pr == 0) ? 64 : 0) + qj, 129, 1, lane);
            else mm32<64>(acc, sQK + qi * 65, 65, 1, sX + ((pr == 2) ? 64 : 0) + qj, 129, 1, lane);
            float* dst = scr + ((pr == 0) ? SC_GT : (pr == 1) ? SC_GR : (pr == 2) ? SC_GQ : SC_GO) + (size_t)item * 4096;
#pragma unroll
            for (int r = 0; r < 16; ++r) { const int i = qi + MM_ROW(r, lane), j = qj + (lane & 31); float v = acc[r];
                if (pr == 0) v = ((i == j) ? dn : 0.f) - v;
                if (pr == 2) v = sq[i * 65 + j] * __expf(sG[i]) - v;
                dst[i * 64 + j] = v; } }
    }
    __syncthreads();
}
__device__ __forceinline__ void gdn_scan(int WV, const KP& p, int L, float* scr, int job, float* sm) {
    const int tid = otid(WV), bh = job >> 3, vs = job & 7, b = bh >> 2, h = bh & 3, k = tid >> 3, kh = (tid >> 2) & 1, jq = tid & 3;
    float* S0 = sm; float* S1 = sm + 544;
    for (int i = tid; i < 544; i += 512) S0[i] = 0.f;
    __syncthreads();
    const float* Tb = scr + SC_GT + (size_t)(b * 32 * 4 + h) * 4096 + k * 64 + kh * 32;
    const float* Rb = scr + SC_GR + (size_t)(b * 32 * 4 + h) * 4096 + k * 64 + vs * 8 + jq;
    float* Gb = scr + SC_GS + (size_t)(b * 32 * 4 + h) * 4096 + k * 64 + vs * 8 + jq;
    f32x4 tq[4][8]; float rq[4][2];
#pragma unroll
    for (int d = 0; d < 3; ++d) {
#pragma unroll
        for (int i = 0; i < 8; ++i) tq[d][i] = *(const f32x4*)(Tb + (size_t)d * 16384 + 4 * i);
        rq[d][0] = Rb[(size_t)d * 16384]; rq[d][1] = Rb[(size_t)d * 16384 + 4]; }
    for (int n4 = 0; n4 < 8; ++n4) {
#pragma unroll
        for (int u = 0; u < 4; ++u) { const int n = n4 * 4 + u, np = (n + 3 < 32) ? n + 3 : 31;
            {
#pragma unroll
                for (int i = 0; i < 8; ++i) tq[(u + 3) & 3][i] = *(const f32x4*)(Tb + (size_t)np * 16384 + 4 * i);
                rq[(u + 3) & 3][0] = Rb[(size_t)np * 16384]; rq[(u + 3) & 3][1] = Rb[(size_t)np * 16384 + 4]; }
            const float* Sc = (n & 1) ? S1 : S0; float* Sn = (n & 1) ? S0 : S1;
            if (kh == 0) { Gb[(size_t)n * 16384] = Sc[jq * 68 + k]; Gb[(size_t)n * 16384 + 4] = Sc[(jq + 4) * 68 + k]; }
            float a0 = 0.f, a1 = 0.f;
#pragma unroll
            for (int i = 0; i < 8; ++i) { const f32x4 s0 = *(const f32x4*)(Sc + jq * 68 + kh * 32 + 4 * i), s1 = *(const f32x4*)(Sc + (jq + 4) * 68 + kh * 32 + 4 * i); const f32x4 t = tq[u][i];
                a0 += t[0] * s0[0] + t[1] * s0[1] + t[2] * s0[2] + t[3] * s0[3]; a1 += t[0] * s1[0] + t[1] * s1[1] + t[2] * s1[2] + t[3] * s1[3]; }
            a0 += swz<4>(a0); a1 += swz<4>(a1);
            if (kh == 0) { Sn[jq * 68 + k] = a0 + rq[u][0]; Sn[(jq + 4) * 68 + k] = a1 + rq[u][1]; }
            asm volatile("s_waitcnt lgkmcnt(0)" ::: "memory"); __builtin_amdgcn_s_barrier(); asm volatile("" ::: "memory");
        }
    }
    if (kh == 0) { float* o = p.out + OUT_GDNP + (size_t)((L * 8 + b) * 4 + h) * 4096 + k * 64 + vs * 8 + jq; o[0] = S0[jq * 68 + k]; o[4] = S0[(jq + 4) * 68 + k]; }
    __syncthreads();
}
__device__ __forceinline__ void gdn_partB(int WV, const KP& p, int L, const bf16_t* proj, const float* scr, bf16_t* br, int item, float* sm) {
    const int tid = otid(WV), h = item & 3, n = (item >> 2) & 31, b = item >> 7, t0 = b * 2048 + n * 64;
    float* sA = sm; float* sS = sm + 64 * 65;
    { f32x4 qa[2], sa[2];
#pragma unroll
      for (int i = 0; i < 2; ++i) { const int idx = (tid + 512 * i) * 4; qa[i] = *(const f32x4*)(scr + SC_GQ + (size_t)item * 4096 + idx); sa[i] = *(const f32x4*)(scr + SC_GS + (size_t)item * 4096 + idx); }
#pragma unroll
      for (int i = 0; i < 2; ++i) { const int idx = (tid + 512 * i) * 4, r = idx >> 6, c = idx & 63;
#pragma unroll
          for (int e = 0; e < 4; ++e) { sA[r * 65 + c + e] = qa[i][e]; sS[r * 68 + c + e] = sa[i][e]; } } }
    __syncthreads();
    const int ti = tid >> 4, tj = tid & 15, i0 = 2 * ti, j0 = 4 * tj;
    uint2 zraw[2];
#pragma unroll
    for (int a = 0; a < 2; ++a) zraw[a] = *(const uint2*)(proj + (size_t)(t0 + i0 + a) * NINP + C_DZ + h * 64 + j0);
    float o[2][4];
#pragma unroll
    for (int a = 0; a < 2; ++a) { const f32x4 v = *(const f32x4*)(scr + SC_GO + (size_t)item * 4096 + (i0 + a) * 64 + j0); o[a][0] = v[0]; o[a][1] = v[1]; o[a][2] = v[2]; o[a][3] = v[3]; }
#pragma unroll 4
    for (int kx = 0; kx < 64; ++kx) { const float a0 = sA[i0 * 65 + kx], a1 = sA[(i0 + 1) * 65 + kx]; const f32x4 b4 = *(const f32x4*)(sS + kx * 68 + j0);
#pragma unroll
        for (int c = 0; c < 4; ++c) { const float bv = b4[c]; o[0][c] += a0 * bv; o[1][c] += a1 * bv; } }
    const float* gn = p.in[16] + L * 64;
#pragma unroll
    for (int a = 0; a < 2; ++a) { float s = o[a][0] * o[a][0] + o[a][1] * o[a][1] + o[a][2] * o[a][2] + o[a][3] * o[a][3];
        s += swz<1>(s); s += swz<2>(s); s += swz<4>(s); s += swz<8>(s);
        const float rs = rsqrtf(s * (1.f / 64.f) + EPSV); const int row = t0 + i0 + a;
        float z[4]; unpack4(zraw[a], z);
        float y[4];
#pragma unroll
        for (int c = 0; c < 4; ++c) y[c] = o[a][c] * rs * gn[j0 + c] * siluf_(z[c]);
        uint2 w; w.x = pk2(y[0], y[1]); w.y = pk2(y[2], y[3]); *(uint2*)(br + (size_t)1 * MT * 256 + (size_t)row * 256 + h * 64 + j0) = w; }
    __syncthreads();
}
__device__ __forceinline__ void gla_load(int WV, const KP& p, int L, const bf16_t* proj, int item, float* sm) {
    const int tid = otid(WV), h = item & 3, n = (item >> 2) & 31, b = item >> 7, t0 = b * 2048 + n * 64;
    float* sq = sm; float* sk = sq + 64 * 33; float* sb = sk + 64 * 33; float* sv = sb + 64 * 33; float* sga = sv + 64 * 68;
    {
        const int l = tid >> 3, c4 = (tid & 7) * 4; const size_t ro = (size_t)(t0 + l) * NINP;
        const uint2 rq = *(const uint2*)(proj + ro + C_GQ + h * 32 + c4), rk = *(const uint2*)(proj + ro + C_GK + h * 32 + c4);
        uint2 rv[2];
#pragma unroll
        for (int i = 0; i < 2; ++i) { const int idx = tid + 512 * i, lv = idx >> 4, cv = (idx & 15) * 4; rv[i] = *(const uint2*)(proj + (size_t)(t0 + lv) * NINP + C_GV + h * 64 + cv); }
        uint2 rg = make_uint2(0u, 0u); if (tid < 256) rg = *(const uint2*)(proj + (size_t)(t0 + (tid >> 2)) * NINP + C_GA + (tid & 3) * 4);
        float f[4]; unpack4(rq, f);
#pragma unroll
        for (int e = 0; e < 4; ++e) sq[l * 33 + c4 + e] = f[e] * 0.17677669529663687f;
        unpack4(rk, f);
#pragma unroll
        for (int e = 0; e < 4; ++e) sk[l * 33 + c4 + e] = f[e];
#pragma unroll
        for (int i = 0; i < 2; ++i) { const int idx = tid + 512 * i, lv = idx >> 4, cv = (idx & 15) * 4; unpack4(rv[i], f);
#pragma unroll
            for (int e = 0; e < 4; ++e) sv[lv * 68 + cv + e] = f[e]; }
        if (tid < 256) { unpack4(rg, f);
#pragma unroll
            for (int e = 0; e < 4; ++e) sga[(tid >> 2) * 17 + (tid & 3) * 4 + e] = f[e]; }
    }
    const float* wa2 = p.in[10] + (size_t)L * 16 * 128; const float* ba = p.in[11] + L * 128;
    float wa[16]; const int cc = tid & 31;
#pragma unroll
    for (int r = 0; r < 16; ++r) wa[r] = wa2[r * 128 + h * 32 + cc];
    const float bav = ba[h * 32 + cc];
    __syncthreads();
#pragma unroll
    for (int i = 0; i < 4; ++i) { const int l = (tid >> 5) + 16 * i; float x = bav;
#pragma unroll
        for (int r = 0; r < 16; ++r) x += sga[l * 17 + r] * wa[r];
        sb[l * 33 + cc] = logsigm(x) * (1.f / 16.f); }
    __syncthreads();
    if (tid < 32) { float bb[64];
#pragma unroll
        for (int l = 0; l < 64; ++l) bb[l] = sb[l * 33 + tid];
#pragma unroll
        for (int l = 1; l < 64; ++l) bb[l] += bb[l - 1];
#pragma unroll
        for (int l = 0; l < 64; ++l) sb[l * 33 + tid] = bb[l]; }
    __syncthreads();
}
__device__ __forceinline__ void gla_partA(int WV, const KP& p, int L, const bf16_t* proj, float* scr, int item, float* sm) {
    gla_load(WV, p, L, proj, item, sm);
    const int tid = otid(WV);
    float* sk = sm + 64 * 33; float* sb = sk + 64 * 33; float* sv = sb + 64 * 33;
    const int kk = tid >> 4, v0 = (tid & 15) * 4; const float bl = sb[63 * 33 + kk];
    float acc[4] = {0.f, 0.f, 0.f, 0.f};
#pragma unroll 4
    for (int l = 0; l < 64; ++l) { const float ke = sk[l * 33 + kk] * __expf(bl - sb[l * 33 + kk]); const f32x4 v4 = *(const f32x4*)(sv + l * 68 + v0);
#pragma unroll
        for (int c = 0; c < 4; ++c) acc[c] += ke * v4[c]; }
    *(f32x4*)(scr + SC_ADS + (size_t)item * 2048 + kk * 64 + v0) = (f32x4){acc[0], acc[1], acc[2], acc[3]};
    if (tid < 32) scr[SC_ADEC + (size_t)item * 32 + tid] = __expf(sb[63 * 33 + tid]);
    __syncthreads();
}
__device__ __forceinline__ void gla_partB(int WV, const KP& p, int L, const bf16_t* proj, const float* scr, bf16_t* br, int item, float* sm) {
    gla_load(WV, p, L, proj, item, sm);
    const int tid = otid(WV), h = item & 3, n = (item >> 2) & 31, b = item >> 7, t0 = b * 2048 + n * 64;
    float* sq = sm; float* sk = sq + 64 * 33; float* sb = sk + 64 * 33; float* sv = sb + 64 * 33; float* sA = sv + 64 * 68 + 64 * 17; float* sS = sA + 64 * 65;
    for (int idx = tid; idx < 64 * 32; idx += 512) { const int l = idx >> 5, c = idx & 31; const float bb = sb[l * 33 + c]; sq[l * 33 + c] *= __expf(bb); sk[l * 33 + c] *= __expf(-bb); }
    { const f32x4 sv4 = *(const f32x4*)(scr + SC_AS + (size_t)item * 2048 + tid * 4); const int r = (tid * 4) >> 6, c = (tid * 4) & 63;
#pragma unroll
      for (int e = 0; e < 4; ++e) sS[r * 68 + c + e] = sv4[e]; }
    __syncthreads();
    const int ti = tid >> 4, tj = tid & 15, i0 = 2 * ti, j0 = 4 * tj;
    uint2 zraw[2];
#pragma unroll
    for (int a = 0; a < 2; ++a) zraw[a] = *(const uint2*)(proj + (size_t)(t0 + i0 + a) * NINP + C_GR + h * 64 + j0);
    {
        float c1[2][4];
#pragma unroll
        for (int a = 0; a < 2; ++a)
#pragma unroll
            for (int c = 0; c < 4; ++c) c1[a][c] = 0.f;
#pragma unroll 4
        for (int kx = 0; kx < 32; ++kx) { const float a0 = sq[i0 * 33 + kx], a1 = sq[(i0 + 1) * 33 + kx];
#pragma unroll
            for (int c = 0; c < 4; ++c) { const float bv = sk[(j0 + c) * 33 + kx]; c1[0][c] += a0 * bv; c1[1][c] += a1 * bv; } }
#pragma unroll
        for (int a = 0; a < 2; ++a)
#pragma unroll
            for (int c = 0; c < 4; ++c) sA[(i0 + a) * 65 + j0 + c] = (j0 + c <= i0 + a) ? c1[a][c] : 0.f;
    }
    __syncthreads();
    float o[2][4];
#pragma unroll
    for (int a = 0; a < 2; ++a)
#pragma unroll
        for (int c = 0; c < 4; ++c) o[a][c] = 0.f;
#pragma unroll 4
    for (int mm = 0; mm < 64; ++mm) { const float a0 = sA[i0 * 65 + mm], a1 = sA[(i0 + 1) * 65 + mm]; const f32x4 b4 = *(const f32x4*)(sv + mm * 68 + j0);
#pragma unroll
        for (int c = 0; c < 4; ++c) { const float bv = b4[c]; o[0][c] += a0 * bv; o[1][c] += a1 * bv; } }
#pragma unroll 4
    for (int kx = 0; kx < 32; ++kx) { const float a0 = sq[i0 * 33 + kx], a1 = sq[(i0 + 1) * 33 + kx]; const f32x4 b4 = *(const f32x4*)(sS + kx * 68 + j0);
#pragma unroll
        for (int c = 0; c < 4; ++c) { const float bv = b4[c]; o[0][c] += a0 * bv; o[1][c] += a1 * bv; } }
    const float* gn = p.in[12] + L * 64;
#pragma unroll
    for (int a = 0; a < 2; ++a) { float s = o[a][0] * o[a][0] + o[a][1] * o[a][1] + o[a][2] * o[a][2] + o[a][3] * o[a][3];
        s += swz<1>(s); s += swz<2>(s); s += swz<4>(s); s += swz<8>(s);
        const float rs = rsqrtf(s * (1.f / 64.f) + EPSV); const int row = t0 + i0 + a;
        float z[4]; unpack4(zraw[a], z);
        float y[4];
#pragma unroll
        for (int c = 0; c < 4; ++c) y[c] = o[a][c] * rs * gn[j0 + c] * siluf_(z[c]);
        uint2 w; w.x = pk2(y[0], y[1]); w.y = pk2(y[2], y[3]); *(uint2*)(br + (size_t)row * 256 + h * 64 + j0) = w; }
    __syncthreads();
}
__device__ __forceinline__ void cm_prompt(int WV, const KP& p, int L, const bf16_t* proj, bf16_t* br, int item, float* sm) {
    const int tid = otid(WV), lane = tid & 63, wv = tid >> 6, g = item & 3, n = (item >> 2) & 15, b = item >> 6, t0 = b * 2048 + n * 128;
    float* sW = sm; float* sV = sW + 128 * 129;
    const float* lg = p.in[17] + L * 256; const float* lb = p.in[18] + L * 256;
    const float* wsrc = p.in[19] + (size_t)(L * 4 + g) * 128 * 128;
    uint2 raw[16]; f32x4 wq[8];
#pragma unroll
    for (int i = 0; i < 16; ++i) raw[i] = *(const uint2*)(proj + (size_t)(t0 + wv * 16 + i) * NINP + C_CV + lane * 4);
#pragma unroll
    for (int i = 0; i < 8; ++i) wq[i] = *(const f32x4*)(wsrc + (tid + 512 * i) * 4);
    f32x4 lg4 = *(const f32x4*)(lg + lane * 4), lb4 = *(const f32x4*)(lb + lane * 4);
#pragma unroll
    for (int i = 0; i < 16; ++i) { const int t = wv * 16 + i; float x[4]; unpack4(raw[i], x);
#pragma unroll
        for (int c = 0; c < 4; ++c) x[c] = geluf_(x[c]);
        const float mean = wave_sum((x[0] + x[1]) + (x[2] + x[3])) * (1.f / 256.f);
        float d2 = 0.f;
#pragma unroll
        for (int c = 0; c < 4; ++c) { x[c] -= mean; d2 += x[c] * x[c]; }
        const float rstd = rsqrtf(wave_sum(d2) * (1.f / 256.f) + EPSV);
        if ((lane >> 4) == g) {
#pragma unroll
            for (int c = 0; c < 4; ++c) sV[t * 65 + ((lane * 4 + c) & 63)] = x[c] * rstd * lg4[c] + lb4[c]; } }
#pragma unroll
    for (int i = 0; i < 8; ++i) { const int idx = (tid + 512 * i) * 4, t = idx >> 7, s0 = idx & 127;
#pragma unroll
        for (int e = 0; e < 4; ++e) sW[t * 129 + s0 + e] = (s0 + e <= t) ? wq[i][e] : 0.f; }
    __syncthreads();
    const int ti = tid >> 4, tj = tid & 15, i0 = 4 * ti, j0 = 4 * tj;
    uint2 uraw[4];
#pragma unroll
    for (int a = 0; a < 4; ++a) uraw[a] = *(const uint2*)(proj + (size_t)(t0 + i0 + a) * NINP + C_CU + g * 64 + j0);
    float acc[4][4];
#pragma unroll
    for (int a = 0; a < 4; ++a)
#pragma unroll
        for (int c = 0; c < 4; ++c) acc[a][c] = 0.f;
    for (int s = 0; s < i0 + 4; ++s) { float av[4], bv[4];
#pragma unroll
        for (int a = 0; a < 4; ++a) av[a] = sW[(i0 + a) * 129 + s];
#pragma unroll
        for (int c = 0; c < 4; ++c) bv[c] = sV[s * 65 + j0 + c];
#pragma unroll
        for (int a = 0; a < 4; ++a)
#pragma unroll
            for (int c = 0; c < 4; ++c) acc[a][c] += av[a] * bv[c]; }
    const float* bs = p.in[20] + (size_t)(L * 4 + g) * 128;
#pragma unroll
    for (int a = 0; a < 4; ++a) { const int t = i0 + a, row = t0 + t; float uu[4]; unpack4(uraw[a], uu);
        const float bt = bs[t]; float y[4];
#pragma unroll
        for (int c = 0; c < 4; ++c) y[c] = geluf_(uu[c]) * (acc[a][c] + bt);
        uint2 w; w.x = pk2(y[0], y[1]); w.y = pk2(y[2], y[3]); *(uint2*)(br + (size_t)2 * MT * 256 + (size_t)row * 256 + g * 64 + j0) = w; }
    __syncthreads();
}
__device__ __forceinline__ void cm_sample(int WV, const KP& p, int L, const bf16_t* proj, bf16_t* br, int b, float* sm) {
    const int tid = otid(WV), lane = tid & 63, t = tid >> 6, row = MPR + b * 8 + t;
    const float* lg = p.in[17] + L * 256; const float* lb = p.in[18] + L * 256;
    float x[4]; unpack4(*(const uint2*)(proj + (size_t)row * NINP + C_CV + lane * 4), x);
#pragma unroll
    for (int c = 0; c < 4; ++c) x[c] = geluf_(x[c]);
    const float mean = wave_sum((x[0] + x[1]) + (x[2] + x[3])) * (1.f / 256.f);
    float d2 = 0.f;
#pragma unroll
    for (int c = 0; c < 4; ++c) { x[c] -= mean; d2 += x[c] * x[c]; }
    const float rstd = rsqrtf(wave_sum(d2) * (1.f / 256.f) + EPSV);
    f32x4 vn;
#pragma unroll
    for (int c = 0; c < 4; ++c) { const int ch = lane * 4 + c; vn[c] = x[c] * rstd * lg[ch] + lb[ch]; sm[t * 256 + ch] = vn[c]; }
    *(f32x4*)(p.out + OUT_CVS + ((size_t)(L * 128 + b) * 8 + t) * 256 + lane * 4) = vn;
    __syncthreads();
    const int g = lane >> 4; const float* wsrc = p.in[19] + (size_t)(L * 4 + g) * 128 * 128 + t * 128; const float bt = p.in[20][(size_t)(L * 4 + g) * 128 + t];
    float s4[4] = {bt, bt, bt, bt};
    for (int s = 0; s <= t; ++s) { const float w = wsrc[s];
#pragma unroll
        for (int c = 0; c < 4; ++c) s4[c] += w * sm[s * 256 + lane * 4 + c]; }
    float uu[4]; unpack4(*(const uint2*)(proj + (size_t)row * NINP + C_CU + lane * 4), uu);
    uint2 w; w.x = pk2(geluf_(uu[0]) * s4[0], geluf_(uu[1]) * s4[1]); w.y = pk2(geluf_(uu[2]) * s4[2], geluf_(uu[3]) * s4[3]);
    *(uint2*)(br + (size_t)2 * MT * 256 + (size_t)row * 256 + lane * 4) = w;
    __syncthreads();
}
__device__ __forceinline__ void sconv_elem(const KP& p, int L, const bf16_t* proj, bf16_t* br, int idx) {
    const int r = idx >> 6, c4 = (idx & 63) * 4; const bool prm = r < MPR; const int b = prm ? (r >> 11) : ((r - MPR) >> 3), t = prm ? (r & 2047) : ((r - MPR) & 7), T = prm ? 2048 : 8;
    float g0[4], g1[4], g2[4], a[4], bb[4];
    { unpack4(*(const uint2*)(proj + (size_t)r * NINP + C_SC + c4), a); unpack4(*(const uint2*)(proj + (size_t)r * NINP + C_SH + c4), bb);
#pragma unroll
      for (int c = 0; c < 4; ++c) g0[c] = a[c] * bb[c]; }
    const float* st = p.in[5] + (size_t)(L * 128 + b) * 2 * 256;
    if (t >= 1) { unpack4(*(const uint2*)(proj + (size_t)(r - 1) * NINP + C_SC + c4), a); unpack4(*(const uint2*)(proj + (size_t)(r - 1) * NINP + C_SH + c4), bb);
#pragma unroll
        for (int c = 0; c < 4; ++c) g1[c] = a[c] * bb[c]; }
    else {
#pragma unroll
        for (int c = 0; c < 4; ++c) g1[c] = prm ? 0.f : st[256 + c4 + c]; }
    if (t >= 2) { unpack4(*(const uint2*)(proj + (size_t)(r - 2) * NINP + C_SC + c4), a); unpack4(*(const uint2*)(proj + (size_t)(r - 2) * NINP + C_SH + c4), bb);
#pragma unroll
        for (int c = 0; c < 4; ++c) g2[c] = a[c] * bb[c]; }
    else {
#pragma unroll
        for (int c = 0; c < 4; ++c) g2[c] = prm ? 0.f : st[t * 256 + c4 + c]; }
    const float* w = p.in[21] + (size_t)L * 3 * 256; float sb4[4]; unpack4(*(const uint2*)(proj + (size_t)r * NINP + C_SB + c4), sb4);
    float y[4];
#pragma unroll
    for (int c = 0; c < 4; ++c) y[c] = sb4[c] * (w[c4 + c] * g2[c] + w[256 + c4 + c] * g1[c] + w[512 + c4 + c] * g0[c]);
    uint2 o; o.x = pk2(y[0], y[1]); o.y = pk2(y[2], y[3]); *(uint2*)(br + (size_t)3 * MT * 256 + (size_t)r * 256 + c4) = o;
    if (t >= T - 2) { float* dst = p.out + (prm ? OUT_SCP + ((size_t)(L * 8 + b) * 2 + (t - (T - 2))) * 256 : OUT_SCS + ((size_t)(L * 128 + b) * 2 + (t - (T - 2))) * 256) + c4;
        *(f32x4*)dst = (f32x4){g0[0], g0[1], g0[2], g0[3]}; }
}
__device__ __forceinline__ void gla_sample(int WV, const KP& p, int L, const bf16_t* proj, bf16_t* br, int wi, float* sm) {
    const int tid = otid(WV), lane = tid & 63, b = wi >> 2, h = wi & 3, kk = lane & 31; float* wl = sm + (tid >> 6) * 128;
    float S[32];
    const float* s0 = p.in[2] + (size_t)((L * 128 + b) * 4 + h) * 2048 + lane;
#pragma unroll
    for (int k = 0; k < 32; ++k) S[k] = s0[k * 64];
    const float* wa2 = p.in[10] + (size_t)L * 16 * 128; const float bav = p.in[11][L * 128 + h * 32 + kk]; const float gnv = p.in[12][L * 64 + lane];
    for (int t = 0; t < 8; ++t) { const size_t ro = (size_t)(MPR + b * 8 + t) * NINP;
        const float qv = bf2f(proj[ro + C_GQ + h * 32 + kk]) * 0.17677669529663687f, kv = bf2f(proj[ro + C_GK + h * 32 + kk]);
        float x = bav;
#pragma unroll
        for (int r = 0; r < 16; ++r) x += bf2f(proj[ro + C_GA + r]) * wa2[r * 128 + h * 32 + kk];
        const float av = __expf(logsigm(x) * (1.f / 16.f));
        const float v = bf2f(proj[ro + C_GV + h * 64 + lane]);
        float o = 0.f;
        if (lane < 32) { wl[lane] = av; wl[32 + lane] = kv; wl[64 + lane] = qv; }
        __builtin_amdgcn_wave_barrier();
#pragma unroll
        for (int k4 = 0; k4 < 8; ++k4) { const f32x4 a4 = *(const f32x4*)(wl + 4 * k4), k4v = *(const f32x4*)(wl + 32 + 4 * k4), q4 = *(const f32x4*)(wl + 64 + 4 * k4);
#pragma unroll
            for (int c = 0; c < 4; ++c) { S[4 * k4 + c] = a4[c] * S[4 * k4 + c] + k4v[c] * v; o += q4[c] * S[4 * k4 + c]; } }
        __builtin_amdgcn_wave_barrier();
        const float rs = rsqrtf(wave_sum(o * o) * (1.f / 64.f) + EPSV);
        const float y = o * rs * gnv * siluf_(bf2f(proj[ro + C_GR + h * 64 + lane]));
        br[(size_t)(MPR + b * 8 + t) * 256 + h * 64 + lane] = (bf16_t)(pk2(y, 0.f) & 0xffffu);
    }
    const int lane2 = otid(WV) & 63;
    float* so = p.out + OUT_GLAS + (size_t)((L * 128 + b) * 4 + h) * 2048 + lane2;
#pragma unroll
    for (int k = 0; k < 32; ++k) so[k * 64] = S[k];
}
__device__ __forceinline__ void gdn_sample(int WV, const KP& p, int L, const bf16_t* proj, bf16_t* br, int wi, float* sm) {
    const int tid = otid(WV), lane = tid & 63, b = wi >> 2, h = wi & 3; float* wl = sm + (tid >> 6) * 128;
    float S[64];
    const float* s0 = p.in[3] + (size_t)((L * 128 + b) * 4 + h) * 4096 + lane;
#pragma unroll
    for (int k = 0; k < 64; ++k) S[k] = s0[k * 64];
    const float* cw = p.in[13] + (size_t)L * 4 * 768; const float* cb = p.in[4] + (size_t)(L * 128 + b) * 3 * 768;
    float w[3][4], xm[3][3];
#pragma unroll
    for (int pt = 0; pt < 3; ++pt) { const int col = pt * 256 + h * 64 + lane;
#pragma unroll
        for (int j = 0; j < 4; ++j) w[pt][j] = cw[j * 768 + col];
#pragma unroll
        for (int j = 0; j < 3; ++j) xm[pt][j] = cb[j * 768 + col]; }
    const float nal = -__expf(p.in[14][L * 4 + h]), dtb = p.in[15][L * 4 + h], gnv = p.in[16][L * 64 + lane];
    for (int t = 0; t < 8; ++t) { const int row = MPR + b * 8 + t; const size_t ro = (size_t)row * NINP;
        float y[3];
#pragma unroll
        for (int pt = 0; pt < 3; ++pt) { const float xc = bf2f(proj[ro + C_DQ + pt * 256 + h * 64 + lane]);
            y[pt] = siluf_(w[pt][0] * xm[pt][0] + w[pt][1] * xm[pt][1] + w[pt][2] * xm[pt][2] + w[pt][3] * xc);
            xm[pt][0] = xm[pt][1]; xm[pt][1] = xm[pt][2]; xm[pt][2] = xc; }
        const float q = y[0] * rsqrtf(wave_sum(y[0] * y[0]) + EPSV) * 0.125f, kx = y[1] * rsqrtf(wave_sum(y[1] * y[1]) + EPSV), v = y[2];
        const float eg = __expf(nal * softplusf_(bf2f(proj[ro + C_DA + h]) + dtb)), beta = sigm(bf2f(proj[ro + C_DB + h]));
        float kS = 0.f;
        wl[lane] = kx; wl[64 + lane] = q;
        __builtin_amdgcn_wave_barrier();
#pragma unroll
        for (int k4 = 0; k4 < 16; ++k4) { const f32x4 k4v = *(const f32x4*)(wl + 4 * k4);
#pragma unroll
            for (int c = 0; c < 4; ++c) kS += k4v[c] * S[4 * k4 + c]; }
        const float wv_ = beta * (v - eg * kS);
        float o = 0.f;
#pragma unroll
        for (int k4 = 0; k4 < 16; ++k4) { const f32x4 k4v = *(const f32x4*)(wl + 4 * k4), q4 = *(const f32x4*)(wl + 64 + 4 * k4);
#pragma unroll
            for (int c = 0; c < 4; ++c) { S[4 * k4 + c] = eg * S[4 * k4 + c] + k4v[c] * wv_; o += q4[c] * S[4 * k4 + c]; } }
        __builtin_amdgcn_wave_barrier();
        const float rs = rsqrtf(wave_sum(o * o) * (1.f / 64.f) + EPSV);
        const float yo = o * rs * gnv * siluf_(bf2f(proj[ro + C_DZ + h * 64 + lane]));
        br[(size_t)MT * 256 + (size_t)row * 256 + h * 64 + lane] = (bf16_t)(pk2(yo, 0.f) & 0xffffu);
    }
    const int lane2 = otid(WV) & 63;
    float* so = p.out + OUT_GDNS + (size_t)((L * 128 + b) * 4 + h) * 4096 + lane2;
#pragma unroll
    for (int k = 0; k < 64; ++k) so[k * 64] = S[k];
    float* co = p.out + OUT_GCS + (size_t)(L * 128 + b) * 3 * 768 + h * 64 + lane2;
#pragma unroll
    for (int pt = 0; pt < 3; ++pt)
#pragma unroll
        for (int j = 0; j < 3; ++j) co[j * 768 + pt * 256] = xm[pt][j];
}


#define XB_TMO      128
#define XB_XCNT(j)  (256  + 64 * (j))
#define XB_XSUB(j)  (1280 + 64 * (j))
#define XB_XGEN(j)  (2304 + 64 * (j))
#define XB_TOP      3328
#define XB_TOPGEN   3392
#define XCD_BAR_WORDS 3456
#define XB_SPIN_CAP (1u << 18)
__device__ __forceinline__ unsigned xb_ld(unsigned* p)              { return __hip_atomic_load(p, __ATOMIC_RELAXED, __HIP_MEMORY_SCOPE_AGENT); }
__device__ __forceinline__ unsigned xb_add(unsigned* p, unsigned v) { return __hip_atomic_fetch_add(p, v, __ATOMIC_RELAXED, __HIP_MEMORY_SCOPE_AGENT); }
__device__ __forceinline__ unsigned xb_xcc_id() { return (unsigned)__builtin_amdgcn_s_getreg((3 << 11) | 20) & 0xFu; }
#define XB_SPIN(cond, bar) do { unsigned _sp = 0; while (cond) { __builtin_amdgcn_s_sleep(1); \
    if ((++_sp & 255u) == 0u) { if (xb_ld(&(bar)[XB_TMO])) break; if (_sp > XB_SPIN_CAP) { atomicAdd(&(bar)[XB_TMO], 1u); break; } } } } while (0)
__device__ __forceinline__ void xcd_barrier_complete(unsigned* bar, unsigned x, unsigned& nloc, unsigned& nx) {
    const unsigned G = gridDim.x;
    unsigned sum, cnt, mine, sp = 0u;
    for (;;) {
        sum = 0u; cnt = 0u; mine = 0u;
#pragma unroll
        for (unsigned j = 0; j < 16; ++j) { const unsigned c = xb_ld(&bar[XB_XCNT(j)]); sum += c; cnt += (c > 0u) ? 1u : 0u; mine = (j == x) ? c : mine; }
        if (sum == G) break;
        __builtin_amdgcn_s_sleep(1);
        if ((++sp & 255u) == 0u) { if (xb_ld(&bar[XB_TMO])) break; if (sp > XB_SPIN_CAP) { atomicAdd(&bar[XB_TMO], 1u); break; } }
    }
    nloc = mine > 0u ? mine : 1u; nx = cnt > 0u ? cnt : 1u;
}
__device__ __forceinline__ void xcd_barrier(unsigned* bar, volatile PG8_LAS unsigned* st, bool t0) {
    asm volatile("s_waitcnt vmcnt(0)" ::: "memory");
    __syncthreads();
    if (t0) {
        const unsigned x = xb_xcc_id();
        __builtin_amdgcn_s_waitcnt(0);
        unsigned nloc = st[0], nx = st[1];
        if (nloc == 0u) { xcd_barrier_complete(bar, x, nloc, nx); st[0] = nloc; st[1] = nx; }
        const unsigned old = xb_add(&bar[XB_XSUB(x)], 1u);
        const unsigned gen = old / nloc;
        if (old + 1u == (gen + 1u) * nloc) {
            __builtin_amdgcn_fence(__ATOMIC_RELEASE, "agent");
            asm volatile("s_waitcnt vmcnt(0)" ::: "memory");
            const unsigned og = xb_add(&bar[XB_TOP], 1u);
            const unsigned tg = og / nx;
            if (og + 1u == (tg + 1u) * nx) xb_add(&bar[XB_TOPGEN], 1u);
            else XB_SPIN(xb_ld(&bar[XB_TOPGEN]) == tg, bar);
            __builtin_amdgcn_fence(__ATOMIC_ACQUIRE, "agent");
            xb_add(&bar[XB_XGEN(x)], 1u);
            asm volatile("s_waitcnt vmcnt(0)" ::: "memory");
        } else {
            XB_SPIN(xb_ld(&bar[XB_XGEN(x)]) == gen, bar);
            __builtin_amdgcn_fence(__ATOMIC_ACQUIRE, "agent");
            asm volatile("s_waitcnt vmcnt(0)" ::: "memory");
        }
    }
    __syncthreads();
}
__device__ __forceinline__ const KP& okp() { const __attribute__((address_space(4))) KP* q = (const __attribute__((address_space(4))) KP*)__builtin_amdgcn_kernarg_segment_ptr(); asm volatile("" : "+s"(q)); return *(const KP*)q; }
#define PH_BEGIN { const KP& p = okp(); int WV_ = WV0, nb_ = nb0; asm volatile("" : "+s"(WV_), "+s"(nb_)); const int WV = WV_, nb = nb_; const int bid = obid(), tid = otid(WV), lane = tid & 63, wv = tid >> 6; (void)lane; (void)wv; (void)bid; (void)nb; \
    bf16_t* proj = (bf16_t*)(p.ws + WS_PROJ); bf16_t* gates = (bf16_t*)(p.ws + WS_GATES); float* scr = (float*)(p.ws + WS_GATES); bf16_t* actb = (bf16_t*)(p.ws + WS_GATES); \
    bf16_t* hb = (bf16_t*)(p.ws + ((L & 1) ? WS_HB2 : WS_HB)); bf16_t* hb2 = (bf16_t*)(p.ws + ((L & 1) ? WS_HB : WS_HB2)); (void)hb2; bf16_t* br = (bf16_t*)(p.ws + WS_BR); bf16_t* pb = (bf16_t*)(p.ws + WS_PB); float* ss = (float*)(p.ws + WS_SS); \
    float* mer = (float*)(p.ws + WS_PROJ + PR_MER); bf16_t* merged = (bf16_t*)(p.ws + WS_PROJ + PR_MERGED); float* pe = (float*)(p.ws + WS_PROJ); float* h = p.out; \
    const bf16_t* wb = (const bf16_t*)(p.ws + ((L & 1) ? WS_W1 : WS_W0)); \
    const float* ss0 = ss + (size_t)(3 * L) * MT * 16; float* ss1 = ss + (size_t)(3 * L + 1) * MT * 16; float* ss2 = ss + (size_t)(3 * L + 2) * MT * 16; float* ss3 = ss + (size_t)(3 * L + 3) * MT * 16; \
    (void)proj; (void)gates; (void)scr; (void)actb; (void)hb; (void)br; (void)pb; (void)ss; (void)mer; (void)merged; (void)pe; (void)h; (void)wb; (void)ss0; (void)ss1; (void)ss2; (void)ss3;
#define PH_END }
__global__ void __launch_bounds__(512, 2) mega(KP p_unused) {
    extern __shared__ __attribute__((aligned(16))) unsigned char shm[];
    cg::grid_group grid = cg::this_grid();
    float* sm = (float*)shm;
    const int nb0 = gridDim.x, WV0 = __builtin_amdgcn_readfirstlane(threadIdx.x >> 6);
    volatile PG8_LAS unsigned* xst = (volatile PG8_LAS unsigned*)((PG8_LAS unsigned char*)shm + 131072 + 8192);
    { const int L = 0;
    PH_BEGIN
    if (tid < 4) xst[tid] = 0u;
    if (bid == 0) for (int i = tid; i < 4096; i += 512) ((unsigned*)(p.ws + WS_BAR))[i] = 0u;
    conv_stream(WV, p, 0, (bf16_t*)(p.ws + WS_W0), bid, nb, sm);
    __syncthreads();
    for (int r0 = bid * 8 + wv; r0 < MT; r0 += 2 * nb * 8) { f32x4 v[2][4];
#pragma unroll
        for (int u_ = 0; u_ < 2; ++u_) { const int r = r0 + u_ * nb * 8; if (r < MT) { const float* xr = (r < MPR) ? p.in[0] + (size_t)r * 1024 : p.in[1] + (size_t)(r - MPR) * 1024;
#pragma unroll
            for (int j = 0; j < 4; ++j) v[u_][j] = *(const f32x4*)(xr + j * 256 + lane * 4); } }
#pragma unroll
        for (int u_ = 0; u_ < 2; ++u_) { const int r = r0 + u_ * nb * 8; if (r < MT) { float s_ = 0.f;
#pragma unroll
            for (int j = 0; j < 4; ++j) { const f32x4 x = v[u_][j]; uint2 w; w.x = pk2(x[0], x[1]); w.y = pk2(x[2], x[3]); *(uint2*)(hb + (size_t)r * 1024 + j * 256 + lane * 4) = w; s_ += (x[0] * x[0] + x[1] * x[1]) + (x[2] * x[2] + x[3] * x[3]); }
            s_ = wave_sum(s_); if (lane < 16) ss[(size_t)r * 16 + lane] = (lane == 0) ? s_ : 0.f; } }
    }
    PH_END }
    grid.sync();
    { const KP& p = okp(); if (otid(WV0) == 0) (void)xb_add(&((unsigned*)(p.ws + WS_BAR))[XB_XCNT(xb_xcc_id())], 1u); }
#define GSYNC do { const KP& pq = okp(); xcd_barrier((unsigned*)(pq.ws + WS_BAR), xst, otid(WV0) == 0); } while (0)
#pragma nounroll
    for (int L = 0; L < 4; ++L) {
        for (int rep = 0; rep < REP_S1; ++rep) {
        PH_BEGIN { EpiProj E{proj, NINP, RS_TAB(shm), 0}; run_gemm_rs(WV, shm, hb, wb + O_IN, NINP, 1024, E, ss0); } PH_END
        GSYNC;
        }
        for (int rep = 0; rep < REP_S2; ++rep) {
        PH_BEGIN
        for (int it = bid; it < 1024; it += nb) gdn_partA(WV, p, L, proj, scr, it, sm);
        for (int it = bid; it < 1024; it += nb) gla_partA(WV, p, L, proj, scr, it, sm);
        for (int it = bid; it < 512; it += nb) cm_prompt(WV, p, L, proj, br, it, sm);
        for (int it = (bid + nb - (128 % nb)) % nb; it < 128; it += nb) cm_sample(WV, p, L, proj, br, it, sm);
        for (int it = (bid + nb - (64 % nb)) % nb; it < 64; it += nb) gla_sample(WV, p, L, proj, br, it * 8 + wv, sm);
        for (int it = bid; it < 64; it += nb) gdn_sample(WV, p, L, proj, br, it * 8 + wv, sm);
        for (int i = bid * 512 + tid; i < MT * 64; i += nb * 512) sconv_elem(p, L, proj, br, i);
        PH_END
        GSYNC;
        }
        for (int rep = 0; rep < REP_S34; ++rep) {
        PH_BEGIN
        for (int jb = bid; jb < 256; jb += nb) { const int xcd = jb & 7, slot = jb >> 3, job = (nb == 256) ? (((xcd * 4 + (slot >> 3)) << 3) | (slot & 7)) : jb;
            gdn_scan(WV, p, L, scr, job, sm); }
        for (int e = bid * 512 + tid; e < 65536; e += nb * 512) { const int bh = e >> 11, kv = e & 2047, kk = kv >> 6, b = bh >> 2, hh = bh & 3; float S = 0.f;
            float dsv[32], dcv[32];
#pragma unroll
            for (int n = 0; n < 32; ++n) { const size_t item = (size_t)((b * 32 + n) * 4 + hh); dsv[n] = scr[SC_ADS + item * 2048 + kv]; dcv[n] = scr[SC_ADEC + item * 32 + kk]; }
#pragma unroll
            for (int n = 0; n < 32; ++n) { const size_t item = (size_t)((b * 32 + n) * 4 + hh); scr[SC_AS + item * 2048 + kv] = S; S = dcv[n] * S + dsv[n]; }
            p.out[OUT_GLAP + (size_t)((L * 8 + b) * 4 + hh) * 2048 + kv] = S; }
        for (int i = bid * 512 + tid; i < MT * 64; i += nb * 512) { const int r = i >> 6, c4 = (i & 63) * 4;
            const float* src = (r < MPR) ? p.in[6] + ((size_t)L * MPR + r) * 256 + c4 : p.in[7] + ((size_t)L * 1024 + (r - MPR)) * 256 + c4; const f32x4 v = *(const f32x4*)src;
            uint2 w; w.x = pk2(v[0], v[1]); w.y = pk2(v[2], v[3]); *(uint2*)(pb + (size_t)r * 256 + c4) = w; }
        PH_END
        GSYNC;
        PH_BEGIN
        for (int it = bid; it < 1024; it += nb) gdn_partB(WV, p, L, proj, scr, br, it, sm);
        for (int it = bid; it < 1024; it += nb) gla_partB(WV, p, L, proj, scr, br, it, sm);
        PH_END
        GSYNC;
        }
        for (int rep = 0; rep < REP_S5; ++rep) {
        PH_BEGIN { EpiP E{gates}; GroupOrder S; S.G = nb; S.c = bid; pg8::Gemm gg{br, wb + O_BR, MT, 1024, 256};
            pg8::gemm_phase<EpiP, GroupOrder, false>(WV, (PG8_LAS unsigned char*)shm, gg, S, E, nullptr); } PH_END
        GSYNC;
        }
        for (int rep = 0; rep < REP_S6; ++rep) {
        PH_BEGIN { EpiGateMerge E{gates, merged, RS_TAB(shm), 0}; run_gemm_rs(WV, shm, hb, wb + O_GATE, 4096, 1024, E, ss0); } PH_END
        if (L < 3) { PH_BEGIN unsigned* head = (unsigned*)(p.ws + WS_BAR) + 3840 + 16 * (8 + L); volatile unsigned* sq_ = (volatile unsigned*)(sm + 8192);
            for (;;) { __syncthreads(); if (tid == 0) sq_[0] = atomicAdd(head, 1u); __syncthreads(); const int q = (int)sq_[0]; if (q >= CONV_C1) break;
                conv_job(WV, p, L + 1, (bf16_t*)(p.ws + (((L + 1) & 1) ? WS_W1 : WS_W0)), q, sm); } PH_END }
        GSYNC;
        }
        PH_BEGIN { EpiRes E{hb, hb2, ss1}; run_gemm(WV, shm, merged, wb + O_O, 1024, 1024, E); } PH_END
        PH_BEGIN { EpiF32 E{pe}; TailOrder S; S.init(MT, 1024, nb, bid); S.skip = (nb == 256) ? 16 : 0; pg8::Gemm gg{pb, wb + O_PLE, MT, 1024, 256};
            pg8::gemm_phase<EpiF32, TailOrder, false>(WV, (PG8_LAS unsigned char*)shm, gg, S, E, nullptr); } PH_END
        GSYNC;
        for (int rep = 0; rep < REP_S8; ++rep) {
        PH_BEGIN { EpiGU E{actb, RS_TAB(shm), 0}; run_gemm_rs(WV, shm, hb2, wb + O_GU, 5632, 1024, E, ss1); } PH_END
        GSYNC;
        }
        PH_BEGIN { EpiRes E{hb2, hb, ss2}; run_gemm(WV, shm, actb, wb + O_DN, 1024, DFF, E); } PH_END
        if (L < 3) { PH_BEGIN unsigned* head = (unsigned*)(p.ws + WS_BAR) + 3840 + 16 * L; volatile unsigned* sq_ = (volatile unsigned*)(sm + 8192);
            for (;;) { __syncthreads(); if (tid == 0) sq_[0] = CONV_C1 + atomicAdd(head, 1u); __syncthreads(); const int q = (int)sq_[0]; if (q >= CONV_C2) break;
                conv_job(WV, p, L + 1, (bf16_t*)(p.ws + (((L + 1) & 1) ? WS_W1 : WS_W0)), q, sm); } PH_END }
        GSYNC;
        PH_BEGIN { EpiPG E{hb, hb2, ss3, pe, RS_TAB(shm), 0}; run_gemm_rs(WV, shm, hb, wb + O_PG, 1024, 1024, E, ss2); } PH_END
        if (L < 3) { PH_BEGIN unsigned* head = (unsigned*)(p.ws + WS_BAR) + 3840 + 16 * (4 + L); volatile unsigned* sq_ = (volatile unsigned*)(sm + 8192);
            for (;;) { __syncthreads(); if (tid == 0) sq_[0] = CONV_C2 + atomicAdd(head, 1u); __syncthreads(); const int q = (int)sq_[0]; if (q >= NCONV) break;
                conv_job(WV, p, L + 1, (bf16_t*)(p.ws + (((L + 1) & 1) ? WS_W1 : WS_W0)), q, sm); } PH_END }
        GSYNC;
    }
    { const int L = 0;
    PH_BEGIN const float* ssf = ss + (size_t)12 * MT * 16; const float* gf = p.in[32];
      for (int r0 = bid * 8 + wv; r0 < MT; r0 += 2 * nb * 8) { uint2 hv[2][4]; float rs2[2];
#pragma unroll
          for (int u_ = 0; u_ < 2; ++u_) { const int r = r0 + u_ * nb * 8; if (r < MT) { rs2[u_] = row_rstd(ssf, r);
#pragma unroll
              for (int j = 0; j < 4; ++j) hv[u_][j] = *(const uint2*)(hb + (size_t)r * 1024 + j * 256 + lane * 4); } }
#pragma unroll
          for (int u_ = 0; u_ < 2; ++u_) { const int r = r0 + u_ * nb * 8; if (r < MT) {
#pragma unroll
              for (int j = 0; j < 4; ++j) { float f[4]; unpack4(hv[u_][j], f); const f32x4 gg = *(const f32x4*)(gf + j * 256 + lane * 4);
                  *(f32x4*)(h + (size_t)r * 1024 + j * 256 + lane * 4) = (f32x4){f[0], f[1], f[2], f[3]} * rs2[u_] * gg; } } } }
    PH_END }
}

extern "C" void kernel_launch(void* const* d_in, const int* in_sizes, int n_in, void* d_out, int out_size, void* d_ws, size_t ws_size, hipStream_t stream) {
    constexpr size_t kDynLds = 131072 + 8192 + 16;
    static int grid_blocks = 0;
    if (!grid_blocks) {
        if (n_in != 33 || ws_size < WS_END) { fprintf(stderr, "kernel_launch: bad n_in %d or ws_size %zu < %zu\n", n_in, ws_size, (size_t)WS_END); grid_blocks = -1; return; }
        int dev = 0, cus = 0, per_cu = 0;
        hipGetDevice(&dev); hipDeviceGetAttribute(&cus, hipDeviceAttributeMultiprocessorCount, dev);
        hipFuncSetAttribute((const void*)mega, hipFuncAttributeMaxDynamicSharedMemorySize, (int)kDynLds);
        hipOccupancyMaxActiveBlocksPerMultiprocessor(&per_cu, (const void*)mega, 512, kDynLds);
        if (per_cu < 1) per_cu = 1;
        grid_blocks = cus * per_cu; if (grid_blocks > 256) grid_blocks = 256;
    }
    if (grid_blocks < 0) return;
    KP p{};
    for (int i = 0; i < 33; ++i) p.in[i] = (const float*)d_in[i];
    p.out = (float*)d_out; p.ws = (unsigned char*)d_ws;
    void* args[] = {&p};
    hipError_t e = hipLaunchCooperativeKernel((void*)mega, dim3(grid_blocks), dim3(512), args, kDynLds, stream);
    if (e != hipSuccess) fprintf(stderr, "cooperative launch failed: %s (grid %d)\n", hipGetErrorString(e), grid_blocks);
}
```

```cpp
#include <hip/hip_runtime.h>
#include <hip/hip_cooperative_groups.h>
#include <cstdio>
namespace cg = cooperative_groups;
#define CONV_C1 900
#define CONV_C2 3500
#ifndef REP_S2
#define REP_S2 1
#endif
#ifndef REP_S34
#define REP_S34 1
#endif
#ifndef REP_S1
#define REP_S1 1
#endif
#ifndef REP_S8
#define REP_S8 1
#endif
#ifndef REP_S5
#define REP_S5 1
#endif
#ifndef REP_S6
#define REP_S6 1
#endif
namespace pg8 {
#define PG8_LAS __attribute__((address_space(3)))
typedef unsigned short bf16_t;
typedef short bf16x8 __attribute__((ext_vector_type(8)));
typedef float f32x4 __attribute__((ext_vector_type(4)));
typedef unsigned u32x4 __attribute__((ext_vector_type(4)));
constexpr int BM = 256, BK = 64, HALF = 128, HTB = HALF * BK * 2  , STAGE_BYTES = 8 * HTB, NXCD = 8, WGM = 8;

__host__ __device__ __forceinline__ int lds_byte(int r, int c) { const int st = (r >> 4) * 2 + (c >> 5), rr = r & 15, cc = c & 31, ob = rr * 64 + cc * 2; return st * 1024 + (ob ^ (((ob >> 9) & 1) << 5)); }
__host__ __device__ __forceinline__ void stage_rc(int b, int& R, int& C) { const int st = b / 1024, sb = b % 1024, swz = sb ^ (((sb >> 9) & 1) << 5); R = (st >> 1) * 16 + swz / 64; C = (st & 1) * 32 + (swz % 64) / 2; }
__host__ __device__ __forceinline__ int perm32(int rho) { const int n = rho >> 4, i = rho & 15; return 8 * (i >> 2) + 4 * n + (i & 3); }

struct Unit { int pm, pn; };
struct Gemm { const bf16_t* A; const bf16_t* Bt; int M, N, K; };

struct StaticOrder {
    int nM, nN, nwg, G, c;
    __host__ __device__ void init(int M, int N, int G_, int c_) { nM = M / BM; nN = N / BM; nwg = nM * nN; G = G_; c = c_; }
    __host__ __device__ bool next(int i, Unit& u) const {
        const long L = (long)i * G + c; if (L >= nwg) return false;
        int wgid = (int)L; { const int q = nwg / NXCD, r = nwg % NXCD, xcd = wgid % NXCD, off = wgid / NXCD; wgid = (xcd < r ? xcd * (q + 1) : r * (q + 1) + (xcd - r) * q) + off; }
        const int nig = WGM * nN, gid = wgid / nig, fm = gid * WGM, gsz = (nM - fm) < WGM ? (nM - fm) : WGM;
        u.pm = fm + ((wgid % nig) % gsz); u.pn = (wgid % nig) / gsz; return true;
    }
    __device__ __forceinline__ void a_ready(const Unit&) const {}
    __device__ __forceinline__ void done(const Unit&) const {}
};
__device__ __forceinline__ unsigned cvt_pk_bf16(float lo, float hi) { unsigned r; asm volatile("v_cvt_pk_bf16_f32 %0, %1, %2" : "=v"(r) : "v"(lo), "v"(hi)); return r; }
template <class Epi, class Sched, bool STAMP = false>
__device__ __forceinline__ void gemm_phase(int WV, PG8_LAS unsigned char* lds, const Gemm g, const Sched& S, const Epi& E, unsigned long long* stamps) {
    int lid_; asm volatile("v_mbcnt_lo_u32_b32 %0, -1, 0\n\tv_mbcnt_hi_u32_b32 %0, -1, %0" : "=v"(lid_)); const int tid = WV * 64 + lid_, wid = WV, lane = tid & 63, wr = wid >> 2, wc = wid & 3, fr = lane & 15, fq = lane >> 4;
    const int K = g.K, nt = K / BK;
    int ts_lo = 0, ts_hi = 0, nts = 0; const unsigned long long rt_entry = STAMP ? (unsigned long long)wall_clock64() : 0ull;
#define PG8_STAMP() do { if (STAMP && wid == 0 && nts < 64) { const unsigned long long _c = (unsigned long long)clock64(); \
        ts_lo = (lane == nts) ? (int)(unsigned)_c : ts_lo; ts_hi = (lane == nts) ? (int)(unsigned)(_c >> 32) : ts_hi; ++nts; } } while (0)
    PG8_STAMP();
    unsigned voffA[2], voffB[2];
#pragma unroll
    for (int i = 0; i < 2; ++i) { int R, C; stage_rc(tid * 16 + i * 8192, R, C); const int Rb = Epi::PERM ? ((R & ~31) + perm32(R & 31)) : R;
        voffA[i] = (unsigned)(R * K + C) * 2u; voffB[i] = (unsigned)(Rb * K + C) * 2u; }
    const size_t kstep = (size_t)(BK * 2);
    const size_t hstep = (size_t)HALF * K * 2;
    const size_t tstep = 2 * hstep;
    const unsigned ldsw = (unsigned)wid * 1024u;
    const int aoff = lds_byte(wr * 64 + fr, fq * 8), boff = lds_byte(wc * 32 + fr, fq * 8);
#define PG8_SA(b, h) (((b) * 2 + (h)) * HTB)
#define PG8_SB(b, h) ((4 + (b) * 2 + (h)) * HTB)
#define PG8_STAGE(bufoff, gbase, voff) do { _Pragma("unroll") for (int _i = 0; _i < 2; ++_i) \
        __builtin_amdgcn_global_load_lds((const unsigned*)((const char*)(gbase) + (voff)[_i]), (PG8_LAS unsigned*)(lds + (bufoff) + ldsw + _i * 8192), 16, 0, 0); } while (0)
#define PG8_LDA(dst, b, h) do { _Pragma("unroll") for (int m = 0; m < 4; ++m) _Pragma("unroll") for (int k = 0; k < 2; ++k) dst[m][k] = *(const PG8_LAS bf16x8*)(lds + PG8_SA(b, h) + aoff + m * 2048 + k * 1024); } while (0)
#define PG8_LDB(dst, b, h) do { _Pragma("unroll") for (int n = 0; n < 2; ++n) _Pragma("unroll") for (int k = 0; k < 2; ++k) dst[n][k] = *(const PG8_LAS bf16x8*)(lds + PG8_SB(b, h) + boff + n * 2048 + k * 1024); } while (0)
#define PG8_MMA(ai, bj, At, Bt) do { __builtin_amdgcn_s_setprio(1); _Pragma("unroll") for (int m = 0; m < 4; ++m) _Pragma("unroll") for (int n = 0; n < 2; ++n) _Pragma("unroll") for (int k = 0; k < 2; ++k) \
        acc[ai][bj][m][n] = __builtin_amdgcn_mfma_f32_16x16x32_bf16(Bt[n][k], At[m][k], acc[ai][bj][m][n], 0, 0, 0); __builtin_amdgcn_s_setprio(0); } while (0)
#define PG8_WAIT_V(n) asm volatile("s_waitcnt vmcnt(" #n ")" ::: "memory")
#define PG8_WAIT_L(n) asm volatile("s_waitcnt lgkmcnt(" #n ")" ::: "memory")
#define PG8_BAR __builtin_amdgcn_s_barrier()
#define PG8_SCHED __builtin_amdgcn_sched_barrier(0)
    Unit cur, nxt; int ui = 0;
    if (!S.next(0, cur)) return;
    f32x4 acc[2][2][4][2];
#pragma unroll
    for (int a = 0; a < 2; ++a)
#pragma unroll
        for (int b = 0; b < 2; ++b)
#pragma unroll
            for (int m = 0; m < 4; ++m)
#pragma unroll
                for (int n = 0; n < 2; ++n) acc[a][b][m][n] = (f32x4){0.f, 0.f, 0.f, 0.f};
    if constexpr (Epi::HAS_INIT) E.init(acc, cur, wr, wc, fr, fq);
    bf16x8 At[4][2], B0[2][2], B1[2][2];
    const char* cA = (const char*)g.A + (size_t)cur.pm * tstep; const char* cB = (const char*)g.Bt + (size_t)cur.pn * tstep;
    S.a_ready(cur);
    PG8_STAGE(PG8_SB(0, 0), cB, voffB); PG8_STAGE(PG8_SA(0, 0), cA, voffA); PG8_STAGE(PG8_SB(0, 1), cB + hstep, voffB); PG8_STAGE(PG8_SA(0, 1), cA + hstep, voffA);
    if (wr == 1) PG8_BAR;
    PG8_WAIT_V(4); PG8_BAR;
    PG8_STAGE(PG8_SB(1, 0), cB + kstep, voffB); PG8_STAGE(PG8_SA(1, 0), cA + kstep, voffA); PG8_STAGE(PG8_SB(1, 1), cB + hstep + kstep, voffB);
    PG8_WAIT_V(6); PG8_BAR;
    PG8_STAMP();
    for (;;) {
        const bool has_next = S.next(ui + 1, nxt);
        const char* nA = has_next ? (const char*)g.A + (size_t)nxt.pm * tstep : cA; const char* nB = has_next ? (const char*)g.Bt + (size_t)nxt.pn * tstep : cB;
        for (int t = 0; t < nt; t += 2) {
            const bool last = (t == nt - 2);
            const char* a1 = cA + (size_t)(t + 1) * kstep;
            const char* a2 = last ? nA : cA + (size_t)(t + 2) * kstep; const char* b2 = last ? nB : cB + (size_t)(t + 2) * kstep;
            const char* a3 = a2 + kstep; const char* b3 = b2 + kstep;
            if (last && has_next) S.a_ready(nxt);
            PG8_LDB(B0, 0, 0); PG8_SCHED; PG8_LDA(At, 0, 0); PG8_STAGE(PG8_SA(1, 1), a1 + hstep, voffA);
            PG8_WAIT_L(8); PG8_BAR; PG8_WAIT_L(0); PG8_MMA(0, 0, At, B0); PG8_BAR; PG8_SCHED;
            PG8_LDB(B1, 0, 1); PG8_STAGE(PG8_SB(0, 0), b2, voffB);
            PG8_BAR; PG8_WAIT_L(0); PG8_MMA(0, 1, At, B1); PG8_BAR;
            PG8_LDA(At, 0, 1); PG8_STAGE(PG8_SA(0, 0), a2, voffA);
            PG8_BAR; PG8_WAIT_L(0); PG8_MMA(1, 0, At, B0); PG8_BAR; PG8_SCHED;
            PG8_STAGE(PG8_SB(0, 1), b2 + hstep, voffB);
            PG8_WAIT_V(6); PG8_BAR; PG8_MMA(1, 1, At, B1); PG8_BAR;
            PG8_LDB(B0, 1, 0); PG8_SCHED; PG8_LDA(At, 1, 0); PG8_STAGE(PG8_SA(0, 1), a2 + hstep, voffA);
            PG8_WAIT_L(8); PG8_BAR; PG8_WAIT_L(0); PG8_MMA(0, 0, At, B0); PG8_BAR; PG8_SCHED;
            PG8_LDB(B1, 1, 1); PG8_STAGE(PG8_SB(1, 0), b3, voffB);
            PG8_BAR; PG8_WAIT_L(0); PG8_MMA(0, 1, At, B1); PG8_BAR;
            PG8_LDA(At, 1, 1); PG8_STAGE(PG8_SA(1, 0), a3, voffA);
            PG8_BAR; PG8_WAIT_L(0); PG8_MMA(1, 0, At, B0); PG8_BAR; PG8_SCHED;
            PG8_STAGE(PG8_SB(1, 1), b3 + hstep, voffB);
            PG8_WAIT_V(6); PG8_BAR; PG8_MMA(1, 1, At, B1); PG8_BAR;
        }
        PG8_STAMP();
        if constexpr (!Epi::AFTER_DRAIN) { E(acc, cur, wr, wc, fr, fq); S.done(cur); }
        PG8_STAMP();
        if (!has_next) break;
#pragma unroll
        for (int a = 0; a < 2; ++a)
#pragma unroll
            for (int b = 0; b < 2; ++b)
#pragma unroll
                for (int m = 0; m < 4; ++m)
#pragma unroll
                    for (int n = 0; n < 2; ++n) acc[a][b][m][n] = (f32x4){0.f, 0.f, 0.f, 0.f};
        if constexpr (Epi::HAS_INIT) E.init(acc, nxt, wr, wc, fr, fq);
        cur = nxt; cA = nA; cB = nB; ++ui;
    }
    PG8_WAIT_V(0);
    if (wr == 0) PG8_BAR;
    PG8_BAR;
    if constexpr (Epi::AFTER_DRAIN) { E.fused(acc, cur, wr, wc, fr, fq, lds, wid, lane); S.done(cur); }
    PG8_STAMP();
    if (STAMP && wid == 0) { stamps[lane] = lane < nts ? (((unsigned long long)(unsigned)ts_hi << 32) | (unsigned)ts_lo) : 0ull;
        if (lane == 62) stamps[62] = rt_entry; if (lane == 63) stamps[63] = (unsigned long long)wall_clock64(); }
#undef PG8_STAMP
#undef PG8_SA
#undef PG8_SB
#undef PG8_STAGE
#undef PG8_LDA
#undef PG8_LDB
#undef PG8_MMA
#undef PG8_WAIT_V
#undef PG8_WAIT_L
#undef PG8_BAR
#undef PG8_SCHED
}
}

using pg8::bf16_t; using pg8::f32x4; using pg8::Unit;
constexpr int MT = 17408, MPR = 16384, NINP = 3328, DFF = 2816;
constexpr float EPSV = 1e-6f;
constexpr int C_GQ = 0, C_GK = 128, C_GV = 256, C_GR = 512, C_GA = 768, C_DQ = 784, C_DZ = 1552, C_DA = 1808, C_DB = 1812, C_CU = 1816, C_CV = 2072, C_SH = 2328, C_SB = 2584, C_SC = 2840;
constexpr size_t O_IN = 0, O_GATE = O_IN + (size_t)3328 * 1024, O_BR = O_GATE + (size_t)4096 * 1024, O_O = O_BR + (size_t)1024 * 1024, O_GU = O_O + (size_t)1024 * 1024,
                 O_DN = O_GU + (size_t)5632 * 1024, O_PG = O_DN + (size_t)1024 * 2816, O_PLE = O_PG + (size_t)1024 * 1024, W_ELEMS = O_PLE + (size_t)1024 * 256;
constexpr size_t WS_W0 = 0, WS_W1 = WS_W0 + W_ELEMS * 2, WS_PROJ = WS_W1 + W_ELEMS * 2, WS_GATES = WS_PROJ + (size_t)MT * NINP * 2, WS_HB = WS_GATES + (size_t)MT * 4096 * 2,
                 WS_HB2 = WS_HB + (size_t)MT * 1024 * 2, WS_BR = WS_HB2 + (size_t)MT * 1024 * 2, WS_PB = WS_BR + (size_t)MT * 1024 * 2, WS_SS = WS_PB + (size_t)MT * 256 * 2, WS_BAR = WS_SS + (size_t)13 * MT * 16 * 4, WS_END = WS_BAR + 16384;
constexpr size_t PR_MER = 0, PR_MERGED = (size_t)MT * 1024 * 4;
constexpr size_t SC_GT = 0, SC_GR = SC_GT + (size_t)1024 * 4096, SC_GQ = SC_GR + (size_t)1024 * 4096, SC_GO = SC_GQ + (size_t)1024 * 4096, SC_GS = SC_GO + (size_t)1024 * 4096,
                 SC_ADS = SC_GS + (size_t)1024 * 4096, SC_AS = SC_ADS + (size_t)1024 * 2048, SC_ADEC = SC_AS + (size_t)1024 * 2048, SC_AB = SC_ADEC + (size_t)1024 * 32;
constexpr size_t OUT_GLAP = 17825792, OUT_GLAS = 18087936, OUT_GDNP = 22282240, OUT_GDNS = 22806528, OUT_GCP = 31195136, OUT_GCS = 31268864, OUT_SCP = 32448512, OUT_SCS = 32464896, OUT_CVS = 32727040;

struct KP { const float* in[33]; float* out; unsigned char* ws; };

__device__ __forceinline__ float bf2f(bf16_t b) { return __uint_as_float(((unsigned)b) << 16); }
__device__ __forceinline__ unsigned pk2(float lo, float hi) { return pg8::cvt_pk_bf16(lo, hi); }
__device__ __forceinline__ void unpack4(uint2 v, float* o) { o[0] = __uint_as_float(v.x << 16); o[1] = __uint_as_float(v.x & 0xffff0000u); o[2] = __uint_as_float(v.y << 16); o[3] = __uint_as_float(v.y & 0xffff0000u); }
__device__ __forceinline__ float sigm(float x) { return __builtin_amdgcn_rcpf(1.f + __builtin_amdgcn_exp2f(-1.4426950408889634f * x)); }
__device__ __forceinline__ float siluf_(float x) { return x * sigm(x); }
__device__ __forceinline__ float softplusf_(float x) { return x > 20.f ? x : log1pf(__expf(x)); }
__device__ __forceinline__ float logsigm(float x) { return fminf(x, 0.f) - log1pf(__expf(-fabsf(x))); }
__device__ __forceinline__ float geluf_(float x) { const float y = 0.7978845608f * (x + 0.044715f * x * x * x); return x * (1.f - __builtin_amdgcn_rcpf(1.f + __builtin_amdgcn_exp2f(2.8853900817779268f * y))); }
template <int M> __device__ __forceinline__ float swz(float v) { return __int_as_float(__builtin_amdgcn_ds_swizzle(__float_as_int(v), (M << 10) | 0x1f)); }
__device__ __forceinline__ float bperm(int srclane, float v) { return __int_as_float(__builtin_amdgcn_ds_bpermute(srclane << 2, __float_as_int(v))); }
__device__ __forceinline__ float wave_sum(float v) {
    v += swz<1>(v); v += swz<2>(v); v += swz<4>(v); v += swz<8>(v); v += swz<16>(v);
    return __int_as_float(__builtin_amdgcn_readlane(__float_as_int(v), 0)) + __int_as_float(__builtin_amdgcn_readlane(__float_as_int(v), 32));
}
__device__ __forceinline__ int otid(int WV) { int t; asm volatile("v_mbcnt_lo_u32_b32 %0, -1, 0\n\tv_mbcnt_hi_u32_b32 %0, -1, %0" : "=v"(t)); return WV * 64 + t; }
__device__ __forceinline__ int obid() { int t = blockIdx.x; asm volatile("" : "+s"(t)); return t; }
__device__ __forceinline__ float rdl(float v, int l) { return __int_as_float(__builtin_amdgcn_readlane(__float_as_int(v), l)); }

__device__ __forceinline__ float row_rstd(const float* ssp, int r) { const f32x4* q = (const f32x4*)(ssp + (size_t)r * 16); const f32x4 a = q[0], b = q[1], c = q[2], d = q[3];
    const float s = (((a[0] + a[1]) + (a[2] + a[3])) + ((b[0] + b[1]) + (b[2] + b[3]))) + (((c[0] + c[1]) + (c[2] + c[3])) + ((d[0] + d[1]) + (d[2] + d[3]))); return rsqrtf(s * (1.f / 1024.f) + EPSV); }
#define EPI_ROWS _Pragma("unroll") for (int ai = 0; ai < 2; ++ai) _Pragma("unroll") for (int m = 0; m < 4; ++m)
#define EPI_COLS _Pragma("unroll") for (int bj = 0; bj < 2; ++bj) _Pragma("unroll") for (int n = 0; n < 2; ++n)
#define EPI_R (u.pm * 256 + ai * 128 + wr * 64 + m * 16 + fr)
#define EPI_C (u.pn * 256 + bj * 128 + wc * 32 + n * 16 + 4 * fq)
#define EPI_RSTD8(rs, ssp) const PG8_LAS float* rs = tab + ne * 256 + wr * 64 + fr; ++ne;
#define RS_AT(rs, ssp, ai, m, r) rs[(ai) * 128 + (m) * 16]
struct EpiProj {
    static constexpr bool PERM = true, AFTER_DRAIN = false, HAS_INIT = false;
    bf16_t* O; int ldo; const PG8_LAS float* tab; mutable int ne;
    __device__ __forceinline__ void operator()(const f32x4 (&acc)[2][2][4][2], const Unit& u, int wr, int wc, int fr, int fq) const {
        EPI_RSTD8(rs, ss)
        EPI_ROWS { const int r = EPI_R; const float rstd = RS_AT(rs, ss, ai, m, r);
#pragma unroll
            for (int bj = 0; bj < 2; ++bj) { const int c = u.pn * 256 + bj * 128 + wc * 32 + 8 * fq; const f32x4 v0 = acc[ai][bj][m][0] * rstd, v1 = acc[ai][bj][m][1] * rstd;
                pg8::u32x4 w; w.x = pk2(v0[0], v0[1]); w.y = pk2(v0[2], v0[3]); w.z = pk2(v1[0], v1[1]); w.w = pk2(v1[2], v1[3]); *(pg8::u32x4*)(O + (size_t)r * ldo + c) = w; } }
    }
};
struct EpiP {
    static constexpr bool PERM = true, AFTER_DRAIN = false, HAS_INIT = false;
    bf16_t* P;
    __device__ __forceinline__ void operator()(const f32x4 (&acc)[2][2][4][2], const Unit& u, int wr, int wc, int fr, int fq) const {
        const int g = u.pn >> 2, pm = u.pm - g * 68, pn = u.pn & 3;
        EPI_ROWS { const int r = pm * 256 + ai * 128 + wr * 64 + m * 16 + fr;
#pragma unroll
            for (int bj = 0; bj < 2; ++bj) { const int c = pn * 256 + bj * 128 + wc * 32 + 8 * fq; const f32x4 v0 = acc[ai][bj][m][0], v1 = acc[ai][bj][m][1];
                pg8::u32x4 w; w.x = pk2(v0[0], v0[1]); w.y = pk2(v0[2], v0[3]); w.z = pk2(v1[0], v1[1]); w.w = pk2(v1[2], v1[3]); *(pg8::u32x4*)(P + (size_t)r * 4096 + g * 1024 + c) = w; } }
    }
};
struct EpiGateMerge {
    static constexpr bool PERM = true, AFTER_DRAIN = false, HAS_INIT = false;
    const bf16_t* P; bf16_t* merged; const PG8_LAS float* tab; mutable int ne;
    __device__ __forceinline__ void operator()(const f32x4 (&acc)[2][2][4][2], const Unit& u, int wr, int wc, int fr, int fq) const {
        EPI_RSTD8(rs, ss)
        const int d0 = u.pn * 64 + wc * 16 + 4 * fq;
        uint2 pc[4], pnx[4];
        { const int r = u.pm * 256 + wr * 64 + fr;
#pragma unroll
          for (int g = 0; g < 4; ++g) pc[g] = *(const uint2*)(P + (size_t)r * 4096 + g * 1024 + d0); }
#pragma unroll
        for (int q8 = 0; q8 < 8; ++q8) { const int ai = q8 >> 2, m = q8 & 3; const int r = EPI_R; const float rstd = RS_AT(rs, ss, ai, m, r);
            if (q8 < 7) { const int ai2 = (q8 + 1) >> 2, m2 = (q8 + 1) & 3; const int r2 = u.pm * 256 + ai2 * 128 + wr * 64 + m2 * 16 + fr;
#pragma unroll
                for (int g = 0; g < 4; ++g) pnx[g] = *(const uint2*)(P + (size_t)r2 * 4096 + g * 1024 + d0); }
            f32x4 sum = (f32x4){0.f, 0.f, 0.f, 0.f};
#pragma unroll
            for (int g = 0; g < 4; ++g) { float pv[4]; unpack4(pc[g], pv); const f32x4 a = acc[ai][g >> 1][m][g & 1] * rstd;
                sum[0] += sigm(a[0]) * pv[0]; sum[1] += sigm(a[1]) * pv[1]; sum[2] += sigm(a[2]) * pv[2]; sum[3] += sigm(a[3]) * pv[3]; }
            uint2 w; w.x = pk2(sum[0], sum[1]); w.y = pk2(sum[2], sum[3]); *(uint2*)(merged + (size_t)r * 1024 + d0) = w;
#pragma unroll
            for (int g = 0; g < 4; ++g) pc[g] = pnx[g]; }
    }
};
struct EpiRes {
    static constexpr bool PERM = false, AFTER_DRAIN = false, HAS_INIT = true;
    const bf16_t* hin; bf16_t* hout; float* ssn;
    __device__ __forceinline__ void init(f32x4 (&acc)[2][2][4][2], const Unit& u, int wr, int wc, int fr, int fq) const {
        EPI_ROWS { const int r = EPI_R; EPI_COLS { const int c = EPI_C; float f[4]; unpack4(*(const uint2*)(hin + (size_t)r * 1024 + c), f); acc[ai][bj][m][n] = (f32x4){f[0], f[1], f[2], f[3]}; } }
    }
    __device__ __forceinline__ void operator()(const f32x4 (&acc)[2][2][4][2], const Unit& u, int wr, int wc, int fr, int fq) const {
        EPI_ROWS { const int r = EPI_R; float s = 0.f;
            EPI_COLS { const int c = EPI_C; const f32x4 v = acc[ai][bj][m][n];
                uint2 w; w.x = pk2(v[0], v[1]); w.y = pk2(v[2], v[3]); *(uint2*)(hout + (size_t)r * 1024 + c) = w;
                s += (v[0] * v[0] + v[1] * v[1]) + (v[2] * v[2] + v[3] * v[3]); }
            s += swz<16>(s); s += bperm((fq * 16 + fr) ^ 32, s);
            if (fq == 0) ssn[(size_t)r * 16 + u.pn * 4 + wc] = s; }
    }
};
struct EpiGU {
    static constexpr bool PERM = true, AFTER_DRAIN = false, HAS_INIT = false;
    bf16_t* O; const PG8_LAS float* tab; mutable int ne;
    __device__ __forceinline__ void operator()(const f32x4 (&acc)[2][2][4][2], const Unit& u, int wr, int wc, int fr, int fq) const {
        EPI_RSTD8(rs, ss)
        EPI_ROWS { const int r = EPI_R; const float rstd = RS_AT(rs, ss, ai, m, r); const int c = u.pn * 128 + wc * 32 + 8 * fq;
            const f32x4 g0 = acc[ai][0][m][0] * rstd, g1 = acc[ai][0][m][1] * rstd, u0 = acc[ai][1][m][0] * rstd, u1 = acc[ai][1][m][1] * rstd;
            pg8::u32x4 w; w.x = pk2(siluf_(g0[0]) * u0[0], siluf_(g0[1]) * u0[1]); w.y = pk2(siluf_(g0[2]) * u0[2], siluf_(g0[3]) * u0[3]);
            w.z = pk2(siluf_(g1[0]) * u1[0], siluf_(g1[1]) * u1[1]); w.w = pk2(siluf_(g1[2]) * u1[2], siluf_(g1[3]) * u1[3]);
            *(pg8::u32x4*)(O + (size_t)r * DFF + c) = w; }
    }
};
struct EpiF32 {
    static constexpr bool PERM = false, AFTER_DRAIN = false, HAS_INIT = false;
    float* C;
    __device__ __forceinline__ void operator()(const f32x4 (&acc)[2][2][4][2], const Unit& u, int wr, int wc, int fr, int fq) const {
        EPI_ROWS { const int r = EPI_R; EPI_COLS { const int c = EPI_C; *(f32x4*)(C + (size_t)r * 1024 + c) = acc[ai][bj][m][n]; } }
    }
};
struct EpiPG {
    static constexpr bool PERM = false, AFTER_DRAIN = false, HAS_INIT = false;
    const bf16_t* hin; bf16_t* hout; float* ssn; const float* pe; const PG8_LAS float* tab; mutable int ne;
    __device__ __forceinline__ void operator()(const f32x4 (&acc)[2][2][4][2], const Unit& u, int wr, int wc, int fr, int fq) const {
        EPI_RSTD8(rs, ss)
        uint2 hc[4], hn[4]; f32x4 qc[4], qn[4];
        { const int r = u.pm * 256 + wr * 64 + fr;
#pragma unroll
          for (int q = 0; q < 4; ++q) { const size_t o = (size_t)r * 1024 + u.pn * 256 + (q >> 1) * 128 + wc * 32 + (q & 1) * 16 + 4 * fq; hc[q] = *(const uint2*)(hin + o); qc[q] = *(const f32x4*)(pe + o); } }
#pragma unroll
        for (int q8 = 0; q8 < 8; ++q8) { const int ai = q8 >> 2, m = q8 & 3; const int r = EPI_R; const float rstd = RS_AT(rs, ss, ai, m, r); float s = 0.f;
            if (q8 < 7) { const int ai2 = (q8 + 1) >> 2, m2 = (q8 + 1) & 3; const int r2 = u.pm * 256 + ai2 * 128 + wr * 64 + m2 * 16 + fr;
#pragma unroll
                for (int q = 0; q < 4; ++q) { const size_t o = (size_t)r2 * 1024 + u.pn * 256 + (q >> 1) * 128 + wc * 32 + (q & 1) * 16 + 4 * fq; hn[q] = *(const uint2*)(hin + o); qn[q] = *(const f32x4*)(pe + o); } }
            EPI_COLS { const int c = EPI_C; const f32x4 a = acc[ai][bj][m][n] * rstd; const f32x4 pv = qc[bj * 2 + n]; float v[4]; unpack4(hc[bj * 2 + n], v);
                v[0] += sigm(a[0]) * pv[0]; v[1] += sigm(a[1]) * pv[1]; v[2] += sigm(a[2]) * pv[2]; v[3] += sigm(a[3]) * pv[3];
                uint2 w; w.x = pk2(v[0], v[1]); w.y = pk2(v[2], v[3]); *(uint2*)(hout + (size_t)r * 1024 + c) = w;
                s += (v[0] * v[0] + v[1] * v[1]) + (v[2] * v[2] + v[3] * v[3]); }
            s += swz<16>(s); s += bperm((fq * 16 + fr) ^ 32, s);
            if (fq == 0) ssn[(size_t)r * 16 + u.pn * 4 + wc] = s;
#pragma unroll
            for (int q = 0; q < 4; ++q) { hc[q] = hn[q]; qc[q] = qn[q]; } }
    }
};
struct TailOrder : pg8::StaticOrder {
    int skip;
    __device__ __forceinline__ bool next(int i, Unit& u) const { if (c < skip) return false; pg8::StaticOrder t = *this; t.G = G - skip; t.c = c - skip; return t.next(i, u); }
};
struct GroupOrder {
    int G, c;
    __device__ __forceinline__ bool next(int i, Unit& u) const { const int L0 = i * G + c; if (L0 >= 4 * 272) return false; const int L = ((G & 7) == 0) ? (L0 & 7) * 136 + (L0 >> 3) : L0;
        const int g = L / 272, r = L - g * 272; u.pm = g * 68 + (r >> 2); u.pn = g * 4 + (r & 3); return true; }
    __device__ __forceinline__ void a_ready(const Unit&) const {}
    __device__ __forceinline__ void done(const Unit&) const {}
};
template <class Epi> __device__ __forceinline__ void run_gemm(int WV, unsigned char* shm, const bf16_t* A, const bf16_t* Bt, int N, int K, const Epi& E) {
    pg8::StaticOrder S; S.init(MT, N, (int)gridDim.x, obid());
    pg8::Gemm g{A, Bt, MT, N, K};
#ifndef NO_GEMM
    pg8::gemm_phase<Epi, pg8::StaticOrder, false>(WV, (PG8_LAS unsigned char*)shm, g, S, E, nullptr);
#endif
}

#define RS_TAB(shm) ((PG8_LAS float*)((PG8_LAS unsigned char*)(shm) + 131072))
template <class Epi> __device__ __forceinline__ void run_gemm_rs(int WV, unsigned char* shm, const bf16_t* A, const bf16_t* Bt, int N, int K, const Epi& E, const float* ssp) {
    pg8::StaticOrder S; S.init(MT, N, (int)gridDim.x, obid());
    { const int tid = otid(WV); Unit u; PG8_LAS float* tab = RS_TAB(shm);
      if (tid < 256) for (int i = 0; i < 8 && S.next(i, u); ++i) tab[i * 256 + tid] = row_rstd(ssp, u.pm * 256 + tid);
      __syncthreads(); }
    pg8::Gemm g{A, Bt, MT, N, K};
    pg8::gemm_phase<Epi, pg8::StaticOrder, false>(WV, (PG8_LAS unsigned char*)shm, g, S, E, nullptr);
}
__device__ __forceinline__ void conv_tile(int WV, const float* src, int ldsrc, int K, int Nvalid, const float* gain, bf16_t* dst, int blk, int blkstride, int off, int kt, int ntile, float* sm) {
    const int tid = otid(WV), k0 = kt * 64, n0 = ntile * 64;
#pragma unroll
    for (int i = 0; i < 8; ++i) { const int idx = tid + 512 * i, kk = idx >> 6, jj = idx & 63, j = n0 + jj; float v = 0.f;
        if (j < Nvalid) { v = src[(size_t)(k0 + kk) * ldsrc + j]; if (gain) v *= gain[k0 + kk]; }
        sm[kk * 65 + jj] = v; }
    __syncthreads();
#pragma unroll
    for (int i = 0; i < 4; ++i) { const int idx = tid + 512 * i, jj = idx >> 5, kp = idx & 31, j = n0 + jj; const int drow = (blk < 0) ? (((j & 1023) >> 6) * 256 + 128 * (j >> 11) + 32 * ((j & 63) >> 4) + 8 * ((j >> 2) & 3) + 4 * ((j >> 10) & 1) + (j & 3)) : ((j / blk) * blkstride + off + (j % blk));
        *(unsigned*)(dst + (size_t)drow * K + k0 + 2 * kp) = pk2(sm[(2 * kp) * 65 + jj], sm[(2 * kp + 1) * 65 + jj]); }
    __syncthreads();
}
constexpr int NCONV = 4800;
__device__ __forceinline__ void conv_job(int WV, const KP& p, int L, bf16_t* wb, int q, float* sm) {
    const float* src; int ld, K, Nv, blk = 1 << 30, bs = 0, off = 0, kt, nt; const float* gain = nullptr; bf16_t* dst;
    if (q < 832) { kt = q / 52; nt = q % 52; src = p.in[9] + (size_t)L * 1024 * 3096; ld = 3096; K = 1024; Nv = 3096; gain = p.in[8] + L * 1024; dst = wb + O_IN; }
    else if ((q -= 832) < 1024) { kt = q / 64; nt = q % 64; src = p.in[22] + (size_t)L * 1024 * 4096; ld = 4096; K = 1024; Nv = 4096; gain = p.in[8] + L * 1024; dst = wb + O_GATE; blk = -1; }
    else if ((q -= 1024) < 256) { const int g = q >> 6, r = q & 63; kt = r >> 4; nt = r & 15; src = p.in[23] + (size_t)(L * 4 + g) * 256 * 1024; ld = 1024; K = 256; Nv = 1024; dst = wb + O_BR + (size_t)g * 1024 * 256; }
    else if ((q -= 256) < 256) { kt = q >> 4; nt = q & 15; src = p.in[24] + (size_t)L * 1024 * 1024; ld = 1024; K = 1024; Nv = 1024; dst = wb + O_O; }
    else if ((q -= 256) < 704) { kt = q / 44; nt = q % 44; src = p.in[26] + (size_t)L * 1024 * DFF; ld = DFF; K = 1024; Nv = DFF; gain = p.in[25] + L * 1024; dst = wb + O_GU; blk = 128; bs = 256; off = 0; }
    else if ((q -= 704) < 704) { kt = q / 44; nt = q % 44; src = p.in[27] + (size_t)L * 1024 * DFF; ld = DFF; K = 1024; Nv = DFF; gain = p.in[25] + L * 1024; dst = wb + O_GU; blk = 128; bs = 256; off = 128; }
    else if ((q -= 704) < 704) { kt = q >> 4; nt = q & 15; src = p.in[28] + (size_t)L * DFF * 1024; ld = 1024; K = DFF; Nv = 1024; dst = wb + O_DN; }
    else if ((q -= 704) < 256) { kt = q >> 4; nt = q & 15; src = p.in[30] + (size_t)L * 1024 * 1024; ld = 1024; K = 1024; Nv = 1024; gain = p.in[29] + L * 1024; dst = wb + O_PG; }
    else { q -= 256; kt = q >> 4; nt = q & 15; src = p.in[31] + (size_t)L * 256 * 1024; ld = 1024; K = 256; Nv = 1024; dst = wb + O_PLE; }
    conv_tile(WV, src, ld, K, Nv, gain, dst, blk, bs, off, kt, nt, sm);
}
struct CJ { const float* src; const float* gain; bf16_t* dst; int ld, K, Nv, blk, bs, off, kt, nt; };
__device__ __forceinline__ CJ conv_args(const KP& p, int L, bf16_t* wb, int q) {
    const float* src; int ld, K, Nv, blk = 1 << 30, bs = 0, off = 0, kt, nt; const float* gain = nullptr; bf16_t* dst;
    if (q < 832) { kt = q / 52; nt = q % 52; src = p.in[9] + (size_t)L * 1024 * 3096; ld = 3096; K = 1024; Nv = 3096; gain = p.in[8] + L * 1024; dst = wb + O_IN; }
    else if ((q -= 832) < 1024) { kt = q / 64; nt = q % 64; src = p.in[22] + (size_t)L * 1024 * 4096; ld = 4096; K = 1024; Nv = 4096; gain = p.in[8] + L * 1024; dst = wb + O_GATE; blk = -1; }
    else if ((q -= 1024) < 256) { const int g = q >> 6, r = q & 63; kt = r >> 4; nt = r & 15; src = p.in[23] + (size_t)(L * 4 + g) * 256 * 1024; ld = 1024; K = 256; Nv = 1024; dst = wb + O_BR + (size_t)g * 1024 * 256; }
    else if ((q -= 256) < 256) { kt = q >> 4; nt = q & 15; src = p.in[24] + (size_t)L * 1024 * 1024; ld = 1024; K = 1024; Nv = 1024; dst = wb + O_O; }
    else if ((q -= 256) < 704) { kt = q / 44; nt = q % 44; src = p.in[26] + (size_t)L * 1024 * DFF; ld = DFF; K = 1024; Nv = DFF; gain = p.in[25] + L * 1024; dst = wb + O_GU; blk = 128; bs = 256; off = 0; }
    else if ((q -= 704) < 704) { kt = q / 44; nt = q % 44; src = p.in[27] + (size_t)L * 1024 * DFF; ld = DFF; K = 1024; Nv = DFF; gain = p.in[25] + L * 1024; dst = wb + O_GU; blk = 128; bs = 256; off = 128; }
    else if ((q -= 704) < 704) { kt = q >> 4; nt = q & 15; src = p.in[28] + (size_t)L * DFF * 1024; ld = 1024; K = DFF; Nv = 1024; dst = wb + O_DN; }
    else if ((q -= 704) < 256) { kt = q >> 4; nt = q & 15; src = p.in[30] + (size_t)L * 1024 * 1024; ld = 1024; K = 1024; Nv = 1024; gain = p.in[29] + L * 1024; dst = wb + O_PG; }
    else { q -= 256; kt = q >> 4; nt = q & 15; src = p.in[31] + (size_t)L * 256 * 1024; ld = 1024; K = 256; Nv = 1024; dst = wb + O_PLE; }
    CJ c; c.src = src; c.gain = gain; c.dst = dst; c.ld = ld; c.K = K; c.Nv = Nv; c.blk = blk; c.bs = bs; c.off = off; c.kt = kt; c.nt = nt; return c;
}

#define LBAR() do { asm volatile("s_waitcnt lgkmcnt(0)" ::: "memory"); __builtin_amdgcn_s_barrier(); asm volatile("" ::: "memory"); } while (0)
__device__ __forceinline__ void conv_load(const CJ& c, int tid, float (&v)[8]) {
    const int k0 = c.kt * 64, n0 = c.nt * 64;
#pragma unroll
    for (int i = 0; i < 8; ++i) { const int idx = tid + 512 * i, kk = idx >> 6, jj = idx & 63, j = n0 + jj; float x = 0.f;
        if (j < c.Nv) { x = c.src[(size_t)(k0 + kk) * c.ld + j]; if (c.gain) x *= c.gain[k0 + kk]; }
        v[i] = x; }
}
__device__ __forceinline__ void conv_store(const CJ& c, int tid, const float (&v)[8], float* sm) {
    const int k0 = c.kt * 64, n0 = c.nt * 64;
#pragma unroll
    for (int i = 0; i < 8; ++i) { const int idx = tid + 512 * i, kk = idx >> 6, jj = idx & 63; sm[kk * 65 + jj] = v[i]; }
    LBAR();
#pragma unroll
    for (int i = 0; i < 4; ++i) { const int idx = tid + 512 * i, jj = idx >> 5, kp = idx & 31, j = n0 + jj;
        const int drow = (c.blk < 0) ? (((j & 1023) >> 6) * 256 + 128 * (j >> 11) + 32 * ((j & 63) >> 4) + 8 * ((j >> 2) & 3) + 4 * ((j >> 10) & 1) + (j & 3)) : ((j / c.blk) * c.bs + c.off + (j % c.blk));
        *(unsigned*)(c.dst + (size_t)drow * c.K + k0 + 2 * kp) = pk2(sm[(2 * kp) * 65 + jj], sm[(2 * kp + 1) * 65 + jj]); }
    LBAR();
}
__device__ __forceinline__ void conv_stream(int WV, const KP& p, int L, bf16_t* wb, int q0, int stride, float* sm) {
    const int tid = otid(WV);
    if (q0 >= NCONV) return;
    CJ c = conv_args(p, L, wb, q0); float v[8]; conv_load(c, tid, v);
    for (int q = q0;;) { const int qn = q + stride; const bool has = qn < NCONV; CJ cn = c; float vn[8];
        if (has) { cn = conv_args(p, L, wb, qn); conv_load(cn, tid, vn); }
        conv_store(c, tid, v, sm);
        if (!has) break;
        c = cn; q = qn;
#pragma unroll
        for (int i = 0; i < 8; ++i) v[i] = vn[i]; }
}

typedef float f32x16 __attribute__((ext_vector_type(16)));
template <int K> __device__ __forceinline__ void mm32(f32x16& acc, const float* a, int sai, int sak, const float* b, int sbk, int sbj, int lane) {
    const int l31 = lane & 31, hi = lane >> 5;
    const float* ap = a + l31 * sai + hi * sak; const float* bp = b + hi * sbk + l31 * sbj;
#pragma unroll 8
    for (int k = 0; k < K; k += 2) acc = __builtin_amdgcn_mfma_f32_32x32x2f32(ap[k * sak], bp[k * sbk], acc, 0, 0, 0);
}
#define MM_ROW(r, lane) (((r) & 3) + 8 * ((r) >> 2) + 4 * ((lane) >> 5))
struct MX { const KP* p; int L; const bf16_t* proj; float* scr; bf16_t* br; };

__device__ __forceinline__ void gdn_partA(int WV, const KP& p, int L, const bf16_t* proj, float* scr, int item, float* sm) {
    const int tid = otid(WV), lane = tid & 63, wv = tid >> 6;
    const int h = item & 3, n = (item >> 2) & 31, b = item >> 7, t0 = b * 2048 + n * 64;
    float* sq = sm; float* sk = sq + 64 * 65; float* sv = sk + 64 * 65; float* sMm = sv + 64 * 65; float* sQK = sMm + 64 * 68; float* sX = sQK + 64 * 65; float* sG = sX + 64 * 129; float* sB = sG + 64;
    const float* cw = p.in[13] + (size_t)L * 4 * 768;
    if (tid < 384) {
        const int cq = tid % 48, rg = tid / 48, part = cq >> 4, ch0 = (cq & 15) * 4, col = part * 256 + h * 64 + ch0;
        uint2 raw[11];
#pragma unroll
        for (int i = 0; i < 11; ++i) { const int tt = n * 64 + rg * 8 - 3 + i; raw[i] = (tt >= 0) ? *(const uint2*)(proj + (size_t)(b * 2048 + tt) * NINP + C_DQ + col) : make_uint2(0u, 0u); }
        f32x4 wj[4];
#pragma unroll
        for (int j = 0; j < 4; ++j) wj[j] = *(const f32x4*)(cw + j * 768 + col);
        float xr[11][4];
#pragma unroll
        for (int i = 0; i < 11; ++i) unpack4(raw[i], xr[i]);
        float* dstp = (part == 0 ? sq : (part == 1 ? sk : sv));
#pragma unroll
        for (int i = 0; i < 8; ++i) {
#pragma unroll
            for (int c = 0; c < 4; ++c) { const float y = wj[0][c] * xr[i][c] + wj[1][c] * xr[i + 1][c] + wj[2][c] * xr[i + 2][c] + wj[3][c] * xr[i + 3][c]; dstp[(rg * 8 + i) * 65 + ch0 + c] = siluf_(y); } }
    }
    if (n == 31) for (int idx = tid; idx < 3 * 192; idx += 512) { const int j = idx / 192, cc = idx - j * 192, col = (cc >> 6) * 256 + h * 64 + (cc & 63);
        p.out[OUT_GCP + ((size_t)(L * 8 + b) * 3 + j) * 768 + col] = bf2f(proj[(size_t)(b * 2048 + 2045 + j) * NINP + C_DQ + col]); }
    if (tid < 64) {
        const float a = bf2f(proj[(size_t)(t0 + tid) * NINP + C_DA + h]), bb = bf2f(proj[(size_t)(t0 + tid) * NINP + C_DB + h]);
        float g = -__expf(p.in[14][L * 4 + h]) * softplusf_(a + p.in[15][L * 4 + h]);
        sB[tid] = sigm(bb);
#pragma unroll
        for (int o = 1; o < 64; o <<= 1) { const float t = bperm(tid - o, g); if (tid >= o) g += t; }
        sG[tid] = g;
    }
    __syncthreads();
    for (int i = 0; i < 8; ++i) { const int l = wv * 8 + i; const float x = sq[l * 65 + lane]; float s = wave_sum(x * x); sq[l * 65 + lane] = x * rsqrtf(s + EPSV) * 0.125f;
        const float y = sk[l * 65 + lane]; s = wave_sum(y * y); sk[l * 65 + lane] = y * rsqrtf(s + EPSV); }
    __syncthreads();
    {
        const int pr = wv >> 2, qd = wv & 3, qi = (qd >> 1) * 32, qj = (qd & 1) * 32;
        f32x16 acc;
#pragma unroll
        for (int r = 0; r < 16; ++r) acc[r] = 0.f;
        if (qd != 1) mm32<64>(acc, (pr == 0 ? sk : sq) + qi * 65, 65, 1, sk + qj * 65, 1, 65, lane);
        float* dstm = (pr == 0) ? sMm : sQK;
#pragma unroll
        for (int r = 0; r < 16; ++r) { const int i = qi + MM_ROW(r, lane), j = qj + (lane & 31); const float dec = (j <= i) ? __expf(sG[i] - sG[j]) : 0.f;
            dstm[i * ((pr == 0) ? 68 : 65) + j] = (pr == 0) ? ((j < i) ? sB[i] * dec * acc[r] : 0.f) : dec * acc[r]; }
        for (int idx = tid; idx < 64 * 128; idx += 512) { const int l = idx >> 7, col = idx & 127;
            sX[l * 129 + col] = (col < 64) ? sB[l] * sv[l * 65 + col] : sB[l] * __expf(sG[l]) * sk[l * 65 + col - 64]; }
    }
    __syncthreads();
    for (int I = 0; I < 4; ++I) { const int r0 = I * 16, r1 = r0 + 16;
        if (tid < 128) { float x[16];
#pragma unroll
            for (int l = 0; l < 16; ++l) x[l] = sX[(r0 + l) * 129 + tid];
#pragma unroll
            for (int l = 1; l < 16; ++l) {
#pragma unroll
                for (int mm = 0; mm < l; ++mm) x[l] -= sMm[(r0 + l) * 68 + r0 + mm] * x[mm]; }
#pragma unroll
            for (int l = 1; l < 16; ++l) sX[(r0 + l) * 129 + tid] = x[l]; }
        __syncthreads();
        if (r1 < 64) { const int col = tid & 127, rg = tid >> 7; float xb[16];
#pragma unroll
            for (int mm = 0; mm < 16; ++mm) xb[mm] = sX[(r0 + mm) * 129 + col];
            for (int r = r1 + rg; r < 64; r += 4) { float acc = sX[r * 129 + col]; const f32x4* mp = (const f32x4*)(sMm + r * 68 + r0);
#pragma unroll
                for (int q = 0; q < 4; ++q) { const f32x4 m4 = mp[q]; acc -= m4[0] * xb[4 * q] + m4[1] * xb[4 * q + 1] + m4[2] * xb[4 * q + 2] + m4[3] * xb[4 * q + 3]; }
                sX[r * 129 + col] = acc; } }
        __syncthreads();
    }
    const float g63 = sG[63];
    for (int idx = tid; idx < 64 * 64; idx += 512) { const int l = idx >> 6, c = idx & 63; sk[l * 65 + c] *= __expf(g63 - sG[l]); }
    __syncthreads();
    {
        const float dn = __expf(g63);
#pragma unroll
        for (int jj = 0; jj < 2; ++jj) { const int jb = wv + 8 * jj, pr = jb >> 2, qd = jb & 3, qi = (qd >> 1) * 32, qj = (qd & 1) * 32;
            f32x16 acc;
#pragma unroll
            for (int r = 0; r < 16; ++r) acc[r] = 0.f;
            if (pr < 2) mm32<64>(acc, sk + qi, 1, 65, sX + ((pr == 0) ? 64 : 0) + qj, 129, 1, lane);
            else mm32<64>(acc, sQK + qi * 65, 65, 1, sX + ((pr == 2) ? 64 : 0) + qj, 129, 1, lane);
            float* dst = scr + ((pr == 0) ? SC_GT : (pr == 1) ? SC_GR : (pr == 2) ? SC_GQ : SC_GO) + (size_t)item * 4096;
#pragma unroll
            for (int r = 0; r < 16; ++r) { const int i = qi + MM_ROW(r, lane), j = qj + (lane & 31); float v = acc[r];
                if (pr == 0) v = ((i == j) ? dn : 0.f) - v;
                if (pr == 2) v = sq[i * 65 + j] * __expf(sG[i]) - v;
                dst[i * 64 + j] = v; } }
    }
    __syncthreads();
}
__device__ __forceinline__ void gdn_scan(int WV, const KP& p, int L, float* scr, int job, float* sm) {
    const int tid = otid(WV), bh = job >> 3, vs = job & 7, b = bh >> 2, h = bh & 3, k = tid >> 3, kh = (tid >> 2) & 1, jq = tid & 3;
    float* S0 = sm; float* S1 = sm + 544;
    for (int i = tid; i < 544; i += 512) S0[i] = 0.f;
    __syncthreads();
    const float* Tb = scr + SC_GT + (size_t)(b * 32 * 4 + h) * 4096 + k * 64 + kh * 32;
    const float* Rb = scr + SC_GR + (size_t)(b * 32 * 4 + h) * 4096 + k * 64 + vs * 8 + jq;
    float* Gb = scr + SC_GS + (size_t)(b * 32 * 4 + h) * 4096 + k * 64 + vs * 8 + jq;
    f32x4 tq[4][8]; float rq[4][2];
#pragma unroll
    for (int d = 0; d < 3; ++d) {
#pragma unroll
        for (int i = 0; i < 8; ++i) tq[d][i] = *(const f32x4*)(Tb + (size_t)d * 16384 + 4 * i);
        rq[d][0] = Rb[(size_t)d * 16384]; rq[d][1] = Rb[(size_t)d * 16384 + 4]; }
    for (int n4 = 0; n4 < 8; ++n4) {
#pragma unroll
        for (int u = 0; u < 4; ++u) { const int n = n4 * 4 + u, np = (n + 3 < 32) ? n + 3 : 31;
            {
#pragma unroll
                for (int i = 0; i < 8; ++i) tq[(u + 3) & 3][i] = *(const f32x4*)(Tb + (size_t)np * 16384 + 4 * i);
                rq[(u + 3) & 3][0] = Rb[(size_t)np * 16384]; rq[(u + 3) & 3][1] = Rb[(size_t)np * 16384 + 4]; }
            const float* Sc = (n & 1) ? S1 : S0; float* Sn = (n & 1) ? S0 : S1;
            if (kh == 0) { Gb[(size_t)n * 16384] = Sc[jq * 68 + k]; Gb[(size_t)n * 16384 + 4] = Sc[(jq + 4) * 68 + k]; }
            float a0 = 0.f, a1 = 0.f;
#pragma unroll
            for (int i = 0; i < 8; ++i) { const f32x4 s0 = *(const f32x4*)(Sc + jq * 68 + kh * 32 + 4 * i), s1 = *(const f32x4*)(Sc + (jq + 4) * 68 + kh * 32 + 4 * i); const f32x4 t = tq[u][i];
                a0 += t[0] * s0[0] + t[1] * s0[1] + t[2] * s0[2] + t[3] * s0[3]; a1 += t[0] * s1[0] + t[1] * s1[1] + t[2] * s1[2] + t[3] * s1[3]; }
            a0 += swz<4>(a0); a1 += swz<4>(a1);
            if (kh == 0) { Sn[jq * 68 + k] = a0 + rq[u][0]; Sn[(jq + 4) * 68 + k] = a1 + rq[u][1]; }
            asm volatile("s_waitcnt lgkmcnt(0)" ::: "memory"); __builtin_amdgcn_s_barrier(); asm volatile("" ::: "memory");
        }
    }
    if (kh == 0) { float* o = p.out + OUT_GDNP + (size_t)((L * 8 + b) * 4 + h) * 4096 + k * 64 + vs * 8 + jq; o[0] = S0[jq * 68 + k]; o[4] = S0[(jq + 4) * 68 + k]; }
    __syncthreads();
}
__device__ __forceinline__ void gdn_partB(int WV, const KP& p, int L, const bf16_t* proj, const float* scr, bf16_t* br, int item, float* sm) {
    const int tid = otid(WV), h = item & 3, n = (item >> 2) & 31, b = item >> 7, t0 = b * 2048 + n * 64;
    float* sA = sm; float* sS = sm + 64 * 65;
    { f32x4 qa[2], sa[2];
#pragma unroll
      for (int i = 0; i < 2; ++i) { const int idx = (tid + 512 * i) * 4; qa[i] = *(const f32x4*)(scr + SC_GQ + (size_t)item * 4096 + idx); sa[i] = *(const f32x4*)(scr + SC_GS + (size_t)item * 4096 + idx); }
#pragma unroll
      for (int i = 0; i < 2; ++i) { const int idx = (tid + 512 * i) * 4, r = idx >> 6, c = idx & 63;
#pragma unroll
          for (int e = 0; e < 4; ++e) { sA[r * 65 + c + e] = qa[i][e]; sS[r * 68 + c + e] = sa[i][e]; } } }
    __syncthreads();
    const int ti = tid >> 4, tj = tid & 15, i0 = 2 * ti, j0 = 4 * tj;
    uint2 zraw[2];
#pragma unroll
    for (int a = 0; a < 2; ++a) zraw[a] = *(const uint2*)(proj + (size_t)(t0 + i0 + a) * NINP + C_DZ + h * 64 + j0);
    float o[2][4];
#pragma unroll
    for (int a = 0; a < 2; ++a) { const f32x4 v = *(const f32x4*)(scr + SC_GO + (size_t)item * 4096 + (i0 + a) * 64 + j0); o[a][0] = v[0]; o[a][1] = v[1]; o[a][2] = v[2]; o[a][3] = v[3]; }
#pragma unroll 4
    for (int kx = 0; kx < 64; ++kx) { const float a0 = sA[i0 * 65 + kx], a1 = sA[(i0 + 1) * 65 + kx]; const f32x4 b4 = *(const f32x4*)(sS + kx * 68 + j0);
#pragma unroll
        for (int c = 0; c < 4; ++c) { const float bv = b4[c]; o[0][c] += a0 * bv; o[1][c] += a1 * bv; } }
    const float* gn = p.in[16] + L * 64;
#pragma unroll
    for (int a = 0; a < 2; ++a) { float s = o[a][0] * o[a][0] + o[a][1] * o[a][1] + o[a][2] * o[a][2] + o[a][3] * o[a][3];
        s += swz<1>(s); s += swz<2>(s); s += swz<4>(s); s += swz<8>(s);
        const float rs = rsqrtf(s * (1.f / 64.f) + EPSV); const int row = t0 + i0 + a;
        float z[4]; unpack4(zraw[a], z);
        float y[4];
#pragma unroll
        for (int c = 0; c < 4; ++c) y[c] = o[a][c] * rs * gn[j0 + c] * siluf_(z[c]);
        uint2 w; w.x = pk2(y[0], y[1]); w.y = pk2(y[2], y[3]); *(uint2*)(br + (size_t)1 * MT * 256 + (size_t)row * 256 + h * 64 + j0) = w; }
    __syncthreads();
}
template <int MODE> __device__ __forceinline__ void gla_load(int WV, const KP& p, int L, const bf16_t* proj, float* scr, int item, float* sm) {
    const int tid = otid(WV), h = item & 3, n = (item >> 2) & 31, b = item >> 7, t0 = b * 2048 + n * 64;
    float* sq = sm; float* sk = sq + 64 * 33; float* sb = sk + 64 * 33; float* sv = sb + 64 * 33; float* sga = sv + 64 * 68;
    {
        const int l = tid >> 3, c4 = (tid & 7) * 4; const size_t ro = (size_t)(t0 + l) * NINP;
        const uint2 rq = *(const uint2*)(proj + ro + C_GQ + h * 32 + c4), rk = *(const uint2*)(proj + ro + C_GK + h * 32 + c4);
        uint2 rv[2];
#pragma unroll
        for (int i = 0; i < 2; ++i) { const int idx = tid + 512 * i, lv = idx >> 4, cv = (idx & 15) * 4; rv[i] = *(const uint2*)(proj + (size_t)(t0 + lv) * NINP + C_GV + h * 64 + cv); }
        uint2 rg = make_uint2(0u, 0u); if (MODE == 0 && tid < 256) rg = *(const uint2*)(proj + (size_t)(t0 + (tid >> 2)) * NINP + C_GA + (tid & 3) * 4);
        float f[4]; unpack4(rq, f);
#pragma unroll
        for (int e = 0; e < 4; ++e) sq[l * 33 + c4 + e] = f[e] * 0.17677669529663687f;
        unpack4(rk, f);
#pragma unroll
        for (int e = 0; e < 4; ++e) sk[l * 33 + c4 + e] = f[e];
#pragma unroll
        for (int i = 0; i < 2; ++i) { const int idx = tid + 512 * i, lv = idx >> 4, cv = (idx & 15) * 4; unpack4(rv[i], f);
#pragma unroll
            for (int e = 0; e < 4; ++e) sv[lv * 68 + cv + e] = f[e]; }
        if (MODE == 0 && tid < 256) { unpack4(rg, f);
#pragma unroll
            for (int e = 0; e < 4; ++e) sga[(tid >> 2) * 17 + (tid & 3) * 4 + e] = f[e]; }
    }
    if (MODE == 1) { const f32x4 b4 = *(const f32x4*)(scr + SC_AB + (size_t)item * 2048 + tid * 4); const int l = tid >> 3, c4 = (tid & 7) * 4;
#pragma unroll
        for (int e = 0; e < 4; ++e) sb[l * 33 + c4 + e] = b4[e];
        __syncthreads(); return; }
    const float* wa2 = p.in[10] + (size_t)L * 16 * 128; const float* ba = p.in[11] + L * 128;
    float wa[16]; const int cc = tid & 31;
#pragma unroll
    for (int r = 0; r < 16; ++r) wa[r] = wa2[r * 128 + h * 32 + cc];
    const float bav = ba[h * 32 + cc];
    __syncthreads();
#pragma unroll
    for (int i = 0; i < 4; ++i) { const int l = (tid >> 5) + 16 * i; float x = bav;
#pragma unroll
        for (int r = 0; r < 16; ++r) x += sga[l * 17 + r] * wa[r];
        sb[l * 33 + cc] = logsigm(x) * (1.f / 16.f); }
    __syncthreads();
    if (tid < 32) { float bb[64];
#pragma unroll
        for (int l = 0; l < 64; ++l) bb[l] = sb[l * 33 + tid];
#pragma unroll
        for (int l = 1; l < 64; ++l) bb[l] += bb[l - 1];
#pragma unroll
        for (int l = 0; l < 64; ++l) sb[l * 33 + tid] = bb[l]; }
    __syncthreads();
    { const int l = tid >> 3, c4 = (tid & 7) * 4; *(f32x4*)(scr + SC_AB + (size_t)item * 2048 + tid * 4) = (f32x4){sb[l * 33 + c4], sb[l * 33 + c4 + 1], sb[l * 33 + c4 + 2], sb[l * 33 + c4 + 3]}; }
}
__device__ __forceinline__ void gla_partA(int WV, const KP& p, int L, const bf16_t* proj, float* scr, int item, float* sm) {
    gla_load<0>(WV, p, L, proj, scr, item, sm);
    const int tid = otid(WV);
    float* sk = sm + 64 * 33; float* sb = sk + 64 * 33; float* sv = sb + 64 * 33;
    const int kk = tid >> 4, v0 = (tid & 15) * 4; const float bl = sb[63 * 33 + kk];
    float acc[4] = {0.f, 0.f, 0.f, 0.f};
#pragma unroll 4
    for (int l = 0; l < 64; ++l) { const float ke = sk[l * 33 + kk] * __expf(bl - sb[l * 33 + kk]); const f32x4 v4 = *(const f32x4*)(sv + l * 68 + v0);
#pragma unroll
        for (int c = 0; c < 4; ++c) acc[c] += ke * v4[c]; }
    *(f32x4*)(scr + SC_ADS + (size_t)item * 2048 + kk * 64 + v0) = (f32x4){acc[0], acc[1], acc[2], acc[3]};
    if (tid < 32) scr[SC_ADEC + (size_t)item * 32 + tid] = __expf(sb[63 * 33 + tid]);
    __syncthreads();
}
__device__ __forceinline__ void gla_partB(int WV, const KP& p, int L, const bf16_t* proj, const float* scr, bf16_t* br, int item, float* sm) {
    gla_load<1>(WV, p, L, proj, const_cast<float*>(scr), item, sm);
    const int tid = otid(WV), h = item & 3, n = (item >> 2) & 31, b = item >> 7, t0 = b * 2048 + n * 64;
    float* sq = sm; float* sk = sq + 64 * 33; float* sb = sk + 64 * 33; float* sv = sb + 64 * 33; float* sA = sv + 64 * 68 + 64 * 17; float* sS = sA + 64 * 65;
    for (int idx = tid; idx < 64 * 32; idx += 512) { const int l = idx >> 5, c = idx & 31; const float bb = sb[l * 33 + c]; sq[l * 33 + c] *= __expf(bb); sk[l * 33 + c] *= __expf(-bb); }
    { const f32x4 sv4 = *(const f32x4*)(scr + SC_AS + (size_t)item * 2048 + tid * 4); const int r = (tid * 4) >> 6, c = (tid * 4) & 63;
#pragma unroll
      for (int e = 0; e < 4; ++e) sS[r * 68 + c + e] = sv4[e]; }
    __syncthreads();
    const int ti = tid >> 4, tj = tid & 15, i0 = 2 * ti, j0 = 4 * tj;
    uint2 zraw[2];
#pragma unroll
    for (int a = 0; a < 2; ++a) zraw[a] = *(const uint2*)(proj + (size_t)(t0 + i0 + a) * NINP + C_GR + h * 64 + j0);
    {
        float c1[2][4];
#pragma unroll
        for (int a = 0; a < 2; ++a)
#pragma unroll
            for (int c = 0; c < 4; ++c) c1[a][c] = 0.f;
#pragma unroll 4
        for (int kx = 0; kx < 32; ++kx) { const float a0 = sq[i0 * 33 + kx], a1 = sq[(i0 + 1) * 33 + kx];
#pragma unroll
            for (int c = 0; c < 4; ++c) { const float bv = sk[(j0 + c) * 33 + kx]; c1[0][c] += a0 * bv; c1[1][c] += a1 * bv; } }
#pragma unroll
        for (int a = 0; a < 2; ++a)
#pragma unroll
            for (int c = 0; c < 4; ++c) sA[(i0 + a) * 65 + j0 + c] = (j0 + c <= i0 + a) ? c1[a][c] : 0.f;
    }
    __syncthreads();
    float o[2][4];
#pragma unroll
    for (int a = 0; a < 2; ++a)
#pragma unroll
        for (int c = 0; c < 4; ++c) o[a][c] = 0.f;
#pragma unroll 4
    for (int mm = 0; mm < 64; ++mm) { const float a0 = sA[i0 * 65 + mm], a1 = sA[(i0 + 1) * 65 + mm]; const f32x4 b4 = *(const f32x4*)(sv + mm * 68 + j0);
#pragma unroll
        for (int c = 0; c < 4; ++c) { const float bv = b4[c]; o[0][c] += a0 * bv; o[1][c] += a1 * bv; } }
#pragma unroll 4
    for (int kx = 0; kx < 32; ++kx) { const float a0 = sq[i0 * 33 + kx], a1 = sq[(i0 + 1) * 33 + kx]; const f32x4 b4 = *(const f32x4*)(sS + kx * 68 + j0);
#pragma unroll
        for (int c = 0; c < 4; ++c) { const float bv = b4[c]; o[0][c] += a0 * bv; o[1][c] += a1 * bv; } }
    const float* gn = p.in[12] + L * 64;
#pragma unroll
    for (int a = 0; a < 2; ++a) { float s = o[a][0] * o[a][0] + o[a][1] * o[a][1] + o[a][2] * o[a][2] + o[a][3] * o[a][3];
        s += swz<1>(s); s += swz<2>(s); s += swz<4>(s); s += swz<8>(s);
        const float rs = rsqrtf(s * (1.f / 64.f) + EPSV); const int row = t0 + i0 + a;
        float z[4]; unpack4(zraw[a], z);
        float y[4];
#pragma unroll
        for (int c = 0; c < 4; ++c) y[c] = o[a][c] * rs * gn[j0 + c] * siluf_(z[c]);
        uint2 w; w.x = pk2(y[0], y[1]); w.y = pk2(y[2], y[3]); *(uint2*)(br + (size_t)row * 256 + h * 64 + j0) = w; }
    __syncthreads();
}
__device__ __forceinline__ void cm_prompt(int WV, const KP& p, int L, const bf16_t* proj, bf16_t* br, int item, float* sm) {
    const int tid = otid(WV), lane = tid & 63, wv = tid >> 6, g = item & 3, n = (item >> 2) & 15, b = item >> 6, t0 = b * 2048 + n * 128;
    float* sW = sm; float* sV = sW + 128 * 129;
    const float* lg = p.in[17] + L * 256; const float* lb = p.in[18] + L * 256;
    const float* wsrc = p.in[19] + (size_t)(L * 4 + g) * 128 * 128;
    uint2 raw[16]; f32x4 wq[8];
#pragma unroll
    for (int i = 0; i < 16; ++i) raw[i] = *(const uint2*)(proj + (size_t)(t0 + wv * 16 + i) * NINP + C_CV + lane * 4);
#pragma unroll
    for (int i = 0; i < 8; ++i) wq[i] = *(const f32x4*)(wsrc + (tid + 512 * i) * 4);
    f32x4 lg4 = *(const f32x4*)(lg + lane * 4), lb4 = *(const f32x4*)(lb + lane * 4);
#pragma unroll
    for (int i = 0; i < 16; ++i) { const int t = wv * 16 + i; float x[4]; unpack4(raw[i], x);
#pragma unroll
        for (int c = 0; c < 4; ++c) x[c] = geluf_(x[c]);
        const float mean = wave_sum((x[0] + x[1]) + (x[2] + x[3])) * (1.f / 256.f);
        float d2 = 0.f;
#pragma unroll
        for (int c = 0; c < 4; ++c) { x[c] -= mean; d2 += x[c] * x[c]; }
        const float rstd = rsqrtf(wave_sum(d2) * (1.f / 256.f) + EPSV);
        if ((lane >> 4) == g) {
#pragma unroll
            for (int c = 0; c < 4; ++c) sV[t * 65 + ((lane * 4 + c) & 63)] = x[c] * rstd * lg4[c] + lb4[c]; } }
#pragma unroll
    for (int i = 0; i < 8; ++i) { const int idx = (tid + 512 * i) * 4, t = idx >> 7, s0 = idx & 127;
#pragma unroll
        for (int e = 0; e < 4; ++e) sW[t * 129 + s0 + e] = (s0 + e <= t) ? wq[i][e] : 0.f; }
    __syncthreads();
    const int ti = tid >> 4, tj = tid & 15, i0 = 4 * ti, j0 = 4 * tj;
    uint2 uraw[4];
#pragma unroll
    for (int a = 0; a < 4; ++a) uraw[a] = *(const uint2*)(proj + (size_t)(t0 + i0 + a) * NINP + C_CU + g * 64 + j0);
    float acc[4][4];
#pragma unroll
    for (int a = 0; a < 4; ++a)
#pragma unroll
        for (int c = 0; c < 4; ++c) acc[a][c] = 0.f;
    for (int s = 0; s < i0 + 4; ++s) { float av[4], bv[4];
#pragma unroll
        for (int a = 0; a < 4; ++a) av[a] = sW[(i0 + a) * 129 + s];
#pragma unroll
        for (int c = 0; c < 4; ++c) bv[c] = sV[s * 65 + j0 + c];
#pragma unroll
        for (int a = 0; a < 4; ++a)
#pragma unroll
            for (int c = 0; c < 4; ++c) acc[a][c] += av[a] * bv[c]; }
    const float* bs = p.in[20] + (size_t)(L * 4 + g) * 128;
#pragma unroll
    for (int a = 0; a < 4; ++a) { const int t = i0 + a, row = t0 + t; float uu[4]; unpack4(uraw[a], uu);
        const float bt = bs[t]; float y[4];
#pragma unroll
        for (int c = 0; c < 4; ++c) y[c] = geluf_(uu[c]) * (acc[a][c] + bt);
        uint2 w; w.x = pk2(y[0], y[1]); w.y = pk2(y[2], y[3]); *(uint2*)(br + (size_t)2 * MT * 256 + (size_t)row * 256 + g * 64 + j0) = w; }
    __syncthreads();
}
__device__ __forceinline__ void cm_sample(int WV, const KP& p, int L, const bf16_t* proj, bf16_t* br, int b, float* sm) {
    const int tid = otid(WV), lane = tid & 63, t = tid >> 6, row = MPR + b * 8 + t;
    const float* lg = p.in[17] + L * 256; const float* lb = p.in[18] + L * 256;
    float x[4]; unpack4(*(const uint2*)(proj + (size_t)row * NINP + C_CV + lane * 4), x);
#pragma unroll
    for (int c = 0; c < 4; ++c) x[c] = geluf_(x[c]);
    const float mean = wave_sum((x[0] + x[1]) + (x[2] + x[3])) * (1.f / 256.f);
    float d2 = 0.f;
#pragma unroll
    for (int c = 0; c < 4; ++c) { x[c] -= mean; d2 += x[c] * x[c]; }
    const float rstd = rsqrtf(wave_sum(d2) * (1.f / 256.f) + EPSV);
    f32x4 vn;
#pragma unroll
    for (int c = 0; c < 4; ++c) { const int ch = lane * 4 + c; vn[c] = x[c] * rstd * lg[ch] + lb[ch]; sm[t * 256 + ch] = vn[c]; }
    *(f32x4*)(p.out + OUT_CVS + ((size_t)(L * 128 + b) * 8 + t) * 256 + lane * 4) = vn;
    __syncthreads();
    const int g = lane >> 4; const float* wsrc = p.in[19] + (size_t)(L * 4 + g) * 128 * 128 + t * 128; const float bt = p.in[20][(size_t)(L * 4 + g) * 128 + t];
    float s4[4] = {bt, bt, bt, bt};
    for (int s = 0; s <= t; ++s) { const float w = wsrc[s];
#pragma unroll
        for (int c = 0; c < 4; ++c) s4[c] += w * sm[s * 256 + lane * 4 + c]; }
    float uu[4]; unpack4(*(const uint2*)(proj + (size_t)row * NINP + C_CU + lane * 4), uu);
    uint2 w; w.x = pk2(geluf_(uu[0]) * s4[0], geluf_(uu[1]) * s4[1]); w.y = pk2(geluf_(uu[2]) * s4[2], geluf_(uu[3]) * s4[3]);
    *(uint2*)(br + (size_t)2 * MT * 256 + (size_t)row * 256 + lane * 4) = w;
    __syncthreads();
}
__device__ __forceinline__ void sconv_elem(const KP& p, int L, const bf16_t* proj, bf16_t* br, int idx) {
    const int r = idx >> 6, c4 = (idx & 63) * 4; const bool prm = r < MPR; const int b = prm ? (r >> 11) : ((r - MPR) >> 3), t = prm ? (r & 2047) : ((r - MPR) & 7), T = prm ? 2048 : 8;
    float g0[4], g1[4], g2[4], a[4], bb[4];
    { unpack4(*(const uint2*)(proj + (size_t)r * NINP + C_SC + c4), a); unpack4(*(const uint2*)(proj + (size_t)r * NINP + C_SH + c4), bb);
#pragma unroll
      for (int c = 0; c < 4; ++c) g0[c] = a[c] * bb[c]; }
    const float* st = p.in[5] + (size_t)(L * 128 + b) * 2 * 256;
    if (t >= 1) { unpack4(*(const uint2*)(proj + (size_t)(r - 1) * NINP + C_SC + c4), a); unpack4(*(const uint2*)(proj + (size_t)(r - 1) * NINP + C_SH + c4), bb);
#pragma unroll
        for (int c = 0; c < 4; ++c) g1[c] = a[c] * bb[c]; }
    else {
#pragma unroll
        for (int c = 0; c < 4; ++c) g1[c] = prm ? 0.f : st[256 + c4 + c]; }
    if (t >= 2) { unpack4(*(const uint2*)(proj + (size_t)(r - 2) * NINP + C_SC + c4), a); unpack4(*(const uint2*)(proj + (size_t)(r - 2) * NINP + C_SH + c4), bb);
#pragma unroll
        for (int c = 0; c < 4; ++c) g2[c] = a[c] * bb[c]; }
    else {
#pragma unroll
        for (int c = 0; c < 4; ++c) g2[c] = prm ? 0.f : st[t * 256 + c4 + c]; }
    const float* w = p.in[21] + (size_t)L * 3 * 256; float sb4[4]; unpack4(*(const uint2*)(proj + (size_t)r * NINP + C_SB + c4), sb4);
    float y[4];
#pragma unroll
    for (int c = 0; c < 4; ++c) y[c] = sb4[c] * (w[c4 + c] * g2[c] + w[256 + c4 + c] * g1[c] + w[512 + c4 + c] * g0[c]);
    uint2 o; o.x = pk2(y[0], y[1]); o.y = pk2(y[2], y[3]); *(uint2*)(br + (size_t)3 * MT * 256 + (size_t)r * 256 + c4) = o;
    if (t >= T - 2) { float* dst = p.out + (prm ? OUT_SCP + ((size_t)(L * 8 + b) * 2 + (t - (T - 2))) * 256 : OUT_SCS + ((size_t)(L * 128 + b) * 2 + (t - (T - 2))) * 256) + c4;
        *(f32x4*)dst = (f32x4){g0[0], g0[1], g0[2], g0[3]}; }
}
__device__ __forceinline__ void gla_sample(int WV, const KP& p, int L, const bf16_t* proj, bf16_t* br, int wi, float* sm) {
    const int tid = otid(WV), lane = tid & 63, b = wi >> 2, h = wi & 3, kk = lane & 31; float* wl = sm + (tid >> 6) * 128;
    float S[32];
    const float* s0 = p.in[2] + (size_t)((L * 128 + b) * 4 + h) * 2048 + lane;
#pragma unroll
    for (int k = 0; k < 32; ++k) S[k] = s0[k * 64];
    const float* wa2 = p.in[10] + (size_t)L * 16 * 128; const float bav = p.in[11][L * 128 + h * 32 + kk]; const float gnv = p.in[12][L * 64 + lane];
    for (int t = 0; t < 8; ++t) { const size_t ro = (size_t)(MPR + b * 8 + t) * NINP;
        const float qv = bf2f(proj[ro + C_GQ + h * 32 + kk]) * 0.17677669529663687f, kv = bf2f(proj[ro + C_GK + h * 32 + kk]);
        float x = bav;
#pragma unroll
        for (int r = 0; r < 16; ++r) x += bf2f(proj[ro + C_GA + r]) * wa2[r * 128 + h * 32 + kk];
        const float av = __expf(logsigm(x) * (1.f / 16.f));
        const float v = bf2f(proj[ro + C_GV + h * 64 + lane]);
        float o = 0.f;
        if (lane < 32) { wl[lane] = av; wl[32 + lane] = kv; wl[64 + lane] = qv; }
        __builtin_amdgcn_wave_barrier();
#pragma unroll
        for (int k4 = 0; k4 < 8; ++k4) { const f32x4 a4 = *(const f32x4*)(wl + 4 * k4), k4v = *(const f32x4*)(wl + 32 + 4 * k4), q4 = *(const f32x4*)(wl + 64 + 4 * k4);
#pragma unroll
            for (int c = 0; c < 4; ++c) { S[4 * k4 + c] = a4[c] * S[4 * k4 + c] + k4v[c] * v; o += q4[c] * S[4 * k4 + c]; } }
        __builtin_amdgcn_wave_barrier();
        const float rs = rsqrtf(wave_sum(o * o) * (1.f / 64.f) + EPSV);
        const float y = o * rs * gnv * siluf_(bf2f(proj[ro + C_GR + h * 64 + lane]));
        br[(size_t)(MPR + b * 8 + t) * 256 + h * 64 + lane] = (bf16_t)(pk2(y, 0.f) & 0xffffu);
    }
    const int lane2 = otid(WV) & 63;
    float* so = p.out + OUT_GLAS + (size_t)((L * 128 + b) * 4 + h) * 2048 + lane2;
#pragma unroll
    for (int k = 0; k < 32; ++k) so[k * 64] = S[k];
}
__device__ __forceinline__ void gdn_sample(int WV, const KP& p, int L, const bf16_t* proj, bf16_t* br, int wi, float* sm) {
    const int tid = otid(WV), lane = tid & 63, b = wi >> 2, h = wi & 3; float* wl = sm + (tid >> 6) * 128;
    float S[64];
    const float* s0 = p.in[3] + (size_t)((L * 128 + b) * 4 + h) * 4096 + lane;
#pragma unroll
    for (int k = 0; k < 64; ++k) S[k] = s0[k * 64];
    const float* cw = p.in[13] + (size_t)L * 4 * 768; const float* cb = p.in[4] + (size_t)(L * 128 + b) * 3 * 768;
    float w[3][4], xm[3][3];
#pragma unroll
    for (int pt = 0; pt < 3; ++pt) { const int col = pt * 256 + h * 64 + lane;
#pragma unroll
        for (int j = 0; j < 4; ++j) w[pt][j] = cw[j * 768 + col];
#pragma unroll
        for (int j = 0; j < 3; ++j) xm[pt][j] = cb[j * 768 + col]; }
    const float nal = -__expf(p.in[14][L * 4 + h]), dtb = p.in[15][L * 4 + h], gnv = p.in[16][L * 64 + lane];
    for (int t = 0; t < 8; ++t) { const int row = MPR + b * 8 + t; const size_t ro = (size_t)row * NINP;
        float y[3];
#pragma unroll
        for (int pt = 0; pt < 3; ++pt) { const float xc = bf2f(proj[ro + C_DQ + pt * 256 + h * 64 + lane]);
            y[pt] = siluf_(w[pt][0] * xm[pt][0] + w[pt][1] * xm[pt][1] + w[pt][2] * xm[pt][2] + w[pt][3] * xc);
            xm[pt][0] = xm[pt][1]; xm[pt][1] = xm[pt][2]; xm[pt][2] = xc; }
        const float q = y[0] * rsqrtf(wave_sum(y[0] * y[0]) + EPSV) * 0.125f, kx = y[1] * rsqrtf(wave_sum(y[1] * y[1]) + EPSV), v = y[2];
        const float eg = __expf(nal * softplusf_(bf2f(proj[ro + C_DA + h]) + dtb)), beta = sigm(bf2f(proj[ro + C_DB + h]));
        float kS = 0.f;
        wl[lane] = kx; wl[64 + lane] = q;
        __builtin_amdgcn_wave_barrier();
#pragma unroll
        for (int k4 = 0; k4 < 16; ++k4) { const f32x4 k4v = *(const f32x4*)(wl + 4 * k4);
#pragma unroll
            for (int c = 0; c < 4; ++c) kS += k4v[c] * S[4 * k4 + c]; }
        const float wv_ = beta * (v - eg * kS);
        float o = 0.f;
#pragma unroll
        for (int k4 = 0; k4 < 16; ++k4) { const f32x4 k4v = *(const f32x4*)(wl + 4 * k4), q4 = *(const f32x4*)(wl + 64 + 4 * k4);
#pragma unroll
            for (int c = 0; c < 4; ++c) { S[4 * k4 + c] = eg * S[4 * k4 + c] + k4v[c] * wv_; o += q4[c] * S[4 * k4 + c]; } }
        __builtin_amdgcn_wave_barrier();
        const float rs = rsqrtf(wave_sum(o * o) * (1.f / 64.f) + EPSV);
        const float yo = o * rs * gnv * siluf_(bf2f(proj[ro + C_DZ + h * 64 + lane]));
        br[(size_t)MT * 256 + (size_t)row * 256 + h * 64 + lane] = (bf16_t)(pk2(yo, 0.f) & 0xffffu);
    }
    const int lane2 = otid(WV) & 63;
    float* so = p.out + OUT_GDNS + (size_t)((L * 128 + b) * 4 + h) * 4096 + lane2;
#pragma unroll
    for (int k = 0; k < 64; ++k) so[k * 64] = S[k];
    float* co = p.out + OUT_GCS + (size_t)(L * 128 + b) * 3 * 768 + h * 64 + lane2;
#pragma unroll
    for (int pt = 0; pt < 3; ++pt)
#pragma unroll
        for (int j = 0; j < 3; ++j) co[j * 768 + pt * 256] = xm[pt][j];
}


#define XB_TMO      128
#define XB_XCNT(j)  (256  + 64 * (j))
#define XB_XSUB(j)  (1280 + 64 * (j))
#define XB_XGEN(j)  (2304 + 64 * (j))
#define XB_TOP      3328
#define XB_TOPGEN   3392
#define XCD_BAR_WORDS 3456
#define XB_SPIN_CAP (1u << 18)
__device__ __forceinline__ unsigned xb_ld(unsigned* p)              { return __hip_atomic_load(p, __ATOMIC_RELAXED, __HIP_MEMORY_SCOPE_AGENT); }
__device__ __forceinline__ unsigned xb_add(unsigned* p, unsigned v) { return __hip_atomic_fetch_add(p, v, __ATOMIC_RELAXED, __HIP_MEMORY_SCOPE_AGENT); }
__device__ __forceinline__ unsigned xb_xcc_id() { return (unsigned)__builtin_amdgcn_s_getreg((3 << 11) | 20) & 0xFu; }
#define XB_SPIN(cond, bar) do { unsigned _sp = 0; while (cond) { __builtin_amdgcn_s_sleep(1); \
    if ((++_sp & 255u) == 0u) { if (xb_ld(&(bar)[XB_TMO])) break; if (_sp > XB_SPIN_CAP) { atomicAdd(&(bar)[XB_TMO], 1u); break; } } } } while (0)
__device__ __forceinline__ void xcd_barrier_complete(unsigned* bar, unsigned x, unsigned& nloc, unsigned& nx) {
    const unsigned G = gridDim.x;
    unsigned sum, cnt, mine, sp = 0u;
    for (;;) {
        sum = 0u; cnt = 0u; mine = 0u;
#pragma unroll
        for (unsigned j = 0; j < 16; ++j) { const unsigned c = xb_ld(&bar[XB_XCNT(j)]); sum += c; cnt += (c > 0u) ? 1u : 0u; mine = (j == x) ? c : mine; }
        if (sum == G) break;
        __builtin_amdgcn_s_sleep(1);
        if ((++sp & 255u) == 0u) { if (xb_ld(&bar[XB_TMO])) break; if (sp > XB_SPIN_CAP) { atomicAdd(&bar[XB_TMO], 1u); break; } }
    }
    nloc = mine > 0u ? mine : 1u; nx = cnt > 0u ? cnt : 1u;
}
__device__ __forceinline__ void xcd_barrier(unsigned* bar, volatile PG8_LAS unsigned* st, bool t0) {
    asm volatile("s_waitcnt vmcnt(0)" ::: "memory");
    __syncthreads();
    if (t0) {
        const unsigned x = xb_xcc_id();
        __builtin_amdgcn_s_waitcnt(0);
        unsigned nloc = st[0], nx = st[1];
        if (nloc == 0u) { xcd_barrier_complete(bar, x, nloc, nx); st[0] = nloc; st[1] = nx; }
        const unsigned old = xb_add(&bar[XB_XSUB(x)], 1u);
        const unsigned gen = old / nloc;
        if (old + 1u == (gen + 1u) * nloc) {
            __builtin_amdgcn_fence(__ATOMIC_RELEASE, "agent");
            asm volatile("s_waitcnt vmcnt(0)" ::: "memory");
            const unsigned og = xb_add(&bar[XB_TOP], 1u);
            const unsigned tg = og / nx;
            if (og + 1u == (tg + 1u) * nx) xb_add(&bar[XB_TOPGEN], 1u);
            else XB_SPIN(xb_ld(&bar[XB_TOPGEN]) == tg, bar);
            __builtin_amdgcn_fence(__ATOMIC_ACQUIRE, "agent");
            xb_add(&bar[XB_XGEN(x)], 1u);
            asm volatile("s_waitcnt vmcnt(0)" ::: "memory");
        } else {
            XB_SPIN(xb_ld(&bar[XB_XGEN(x)]) == gen, bar);
            __builtin_amdgcn_fence(__ATOMIC_ACQUIRE, "agent");
            asm volatile("s_waitcnt vmcnt(0)" ::: "memory");
        }
    }
    __syncthreads();
}
__device__ __forceinline__ const KP& okp() { const __attribute__((address_space(4))) KP* q = (const __attribute__((address_space(4))) KP*)__builtin_amdgcn_kernarg_segment_ptr(); asm volatile("" : "+s"(q)); return *(const KP*)q; }
#define PH_BEGIN { const KP& p = okp(); int WV_ = WV0, nb_ = nb0; asm volatile("" : "+s"(WV_), "+s"(nb_)); const int WV = WV_, nb = nb_; const int bid = obid(), tid = otid(WV), lane = tid & 63, wv = tid >> 6; (void)lane; (void)wv; (void)bid; (void)nb; \
    bf16_t* proj = (bf16_t*)(p.ws + WS_PROJ); bf16_t* gates = (bf16_t*)(p.ws + WS_GATES); float* scr = (float*)(p.ws + WS_GATES); bf16_t* actb = (bf16_t*)(p.ws + WS_GATES); \
    bf16_t* hb = (bf16_t*)(p.ws + ((L & 1) ? WS_HB2 : WS_HB)); bf16_t* hb2 = (bf16_t*)(p.ws + ((L & 1) ? WS_HB : WS_HB2)); (void)hb2; bf16_t* br = (bf16_t*)(p.ws + WS_BR); bf16_t* pb = (bf16_t*)(p.ws + WS_PB); float* ss = (float*)(p.ws + WS_SS); \
    float* mer = (float*)(p.ws + WS_PROJ + PR_MER); bf16_t* merged = (bf16_t*)(p.ws + WS_PROJ + PR_MERGED); float* pe = (float*)(p.ws + WS_PROJ); float* h = p.out; \
    const bf16_t* wb = (const bf16_t*)(p.ws + ((L & 1) ? WS_W1 : WS_W0)); \
    const float* ss0 = ss + (size_t)(3 * L) * MT * 16; float* ss1 = ss + (size_t)(3 * L + 1) * MT * 16; float* ss2 = ss + (size_t)(3 * L + 2) * MT * 16; float* ss3 = ss + (size_t)(3 * L + 3) * MT * 16; \
    (void)proj; (void)gates; (void)scr; (void)actb; (void)hb; (void)br; (void)pb; (void)ss; (void)mer; (void)merged; (void)pe; (void)h; (void)wb; (void)ss0; (void)ss1; (void)ss2; (void)ss3;
#define PH_END }
__global__ void __launch_bounds__(512, 2) mega(KP p_unused) {
    extern __shared__ __attribute__((aligned(16))) unsigned char shm[];
    cg::grid_group grid = cg::this_grid();
    float* sm = (float*)shm;
    const int nb0 = gridDim.x, WV0 = __builtin_amdgcn_readfirstlane(threadIdx.x >> 6);
    volatile PG8_LAS unsigned* xst = (volatile PG8_LAS unsigned*)((PG8_LAS unsigned char*)shm + 131072 + 8192);
    { const int L = 0;
    PH_BEGIN
    if (tid < 4) xst[tid] = 0u;
    if (bid == 0) for (int i = tid; i < 4096; i += 512) ((unsigned*)(p.ws + WS_BAR))[i] = 0u;
    conv_stream(WV, p, 0, (bf16_t*)(p.ws + WS_W0), bid, nb, sm);
    __syncthreads();
    for (int r0 = bid * 8 + wv; r0 < MT; r0 += 2 * nb * 8) { f32x4 v[2][4];
#pragma unroll
        for (int u_ = 0; u_ < 2; ++u_) { const int r = r0 + u_ * nb * 8; if (r < MT) { const float* xr = (r < MPR) ? p.in[0] + (size_t)r * 1024 : p.in[1] + (size_t)(r - MPR) * 1024;
#pragma unroll
            for (int j = 0; j < 4; ++j) v[u_][j] = *(const f32x4*)(xr + j * 256 + lane * 4); } }
#pragma unroll
        for (int u_ = 0; u_ < 2; ++u_) { const int r = r0 + u_ * nb * 8; if (r < MT) { float s_ = 0.f;
#pragma unroll
            for (int j = 0; j < 4; ++j) { const f32x4 x = v[u_][j]; uint2 w; w.x = pk2(x[0], x[1]); w.y = pk2(x[2], x[3]); *(uint2*)(hb + (size_t)r * 1024 + j * 256 + lane * 4) = w; s_ += (x[0] * x[0] + x[1] * x[1]) + (x[2] * x[2] + x[3] * x[3]); }
            s_ = wave_sum(s_); if (lane < 16) ss[(size_t)r * 16 + lane] = (lane == 0) ? s_ : 0.f; } }
    }
    PH_END }
    grid.sync();
    { const KP& p = okp(); if (otid(WV0) == 0) (void)xb_add(&((unsigned*)(p.ws + WS_BAR))[XB_XCNT(xb_xcc_id())], 1u); }
#define GSYNC do { const KP& pq = okp(); xcd_barrier((unsigned*)(pq.ws + WS_BAR), xst, otid(WV0) == 0); } while (0)
#pragma nounroll
    for (int L = 0; L < 4; ++L) {
        for (int rep = 0; rep < REP_S1; ++rep) {
        PH_BEGIN { EpiProj E{proj, NINP, RS_TAB(shm), 0}; run_gemm_rs(WV, shm, hb, wb + O_IN, NINP, 1024, E, ss0); } PH_END
        GSYNC;
        }
        for (int rep = 0; rep < REP_S2; ++rep) {
        PH_BEGIN
        for (int it = bid; it < 1024; it += nb) gdn_partA(WV, p, L, proj, scr, it, sm);
        for (int it = bid; it < 1024; it += nb) gla_partA(WV, p, L, proj, scr, it, sm);
        for (int it = bid; it < 512; it += nb) cm_prompt(WV, p, L, proj, br, it, sm);
        for (int it = (bid + nb - (128 % nb)) % nb; it < 128; it += nb) cm_sample(WV, p, L, proj, br, it, sm);
        for (int it = (bid + nb - (64 % nb)) % nb; it < 64; it += nb) gla_sample(WV, p, L, proj, br, it * 8 + wv, sm);
        for (int it = bid; it < 64; it += nb) gdn_sample(WV, p, L, proj, br, it * 8 + wv, sm);
        for (int i = bid * 512 + tid; i < MT * 64; i += nb * 512) sconv_elem(p, L, proj, br, i);
        PH_END
        GSYNC;
        }
        for (int rep = 0; rep < REP_S34; ++rep) {
        PH_BEGIN
        for (int jb = bid; jb < 256; jb += nb) { const int xcd = jb & 7, slot = jb >> 3, job = (nb == 256) ? (((xcd * 4 + (slot >> 3)) << 3) | (slot & 7)) : jb;
            gdn_scan(WV, p, L, scr, job, sm); }
        for (int e = bid * 512 + tid; e < 65536; e += nb * 512) { const int bh = e >> 11, kv = e & 2047, kk = kv >> 6, b = bh >> 2, hh = bh & 3; float S = 0.f;
            float dsv[32], dcv[32];
#pragma unroll
            for (int n = 0; n < 32; ++n) { const size_t item = (size_t)((b * 32 + n) * 4 + hh); dsv[n] = scr[SC_ADS + item * 2048 + kv]; dcv[n] = scr[SC_ADEC + item * 32 + kk]; }
#pragma unroll
            for (int n = 0; n < 32; ++n) { const size_t item = (size_t)((b * 32 + n) * 4 + hh); scr[SC_AS + item * 2048 + kv] = S; S = dcv[n] * S + dsv[n]; }
            p.out[OUT_GLAP + (size_t)((L * 8 + b) * 4 + hh) * 2048 + kv] = S; }
        for (int i = bid * 512 + tid; i < MT * 64; i += nb * 512) { const int r = i >> 6, c4 = (i & 63) * 4;
            const float* src = (r < MPR) ? p.in[6] + ((size_t)L * MPR + r) * 256 + c4 : p.in[7] + ((size_t)L * 1024 + (r - MPR)) * 256 + c4; const f32x4 v = *(const f32x4*)src;
            uint2 w; w.x = pk2(v[0], v[1]); w.y = pk2(v[2], v[3]); *(uint2*)(pb + (size_t)r * 256 + c4) = w; }
        PH_END
        GSYNC;
        PH_BEGIN
        for (int it = bid; it < 1024; it += nb) gdn_partB(WV, p, L, proj, scr, br, it, sm);
        for (int it = bid; it < 1024; it += nb) gla_partB(WV, p, L, proj, scr, br, it, sm);
        PH_END
        GSYNC;
        }
        for (int rep = 0; rep < REP_S5; ++rep) {
        PH_BEGIN { EpiP E{gates}; GroupOrder S; S.G = nb; S.c = bid; pg8::Gemm gg{br, wb + O_BR, MT, 1024, 256};
            pg8::gemm_phase<EpiP, GroupOrder, false>(WV, (PG8_LAS unsigned char*)shm, gg, S, E, nullptr); } PH_END
        GSYNC;
        }
        for (int rep = 0; rep < REP_S6; ++rep) {
        PH_BEGIN { EpiGateMerge E{gates, merged, RS_TAB(shm), 0}; run_gemm_rs(WV, shm, hb, wb + O_GATE, 4096, 1024, E, ss0); } PH_END
        if (L < 3) { PH_BEGIN unsigned* head = (unsigned*)(p.ws + WS_BAR) + 3840 + 16 * (8 + L); volatile unsigned* sq_ = (volatile unsigned*)(sm + 8192);
            for (;;) { __syncthreads(); if (tid == 0) sq_[0] = atomicAdd(head, 1u); __syncthreads(); const int q = (int)sq_[0]; if (q >= CONV_C1) break;
                conv_job(WV, p, L + 1, (bf16_t*)(p.ws + (((L + 1) & 1) ? WS_W1 : WS_W0)), q, sm); } PH_END }
        GSYNC;
        }
        PH_BEGIN { EpiRes E{hb, hb2, ss1}; run_gemm(WV, shm, merged, wb + O_O, 1024, 1024, E); } PH_END
        PH_BEGIN { EpiF32 E{pe}; TailOrder S; S.init(MT, 1024, nb, bid); S.skip = (nb == 256) ? 16 : 0; pg8::Gemm gg{pb, wb + O_PLE, MT, 1024, 256};
            pg8::gemm_phase<EpiF32, TailOrder, false>(WV, (PG8_LAS unsigned char*)shm, gg, S, E, nullptr); } PH_END
        GSYNC;
        for (int rep = 0; rep < REP_S8; ++rep) {
        PH_BEGIN { EpiGU E{actb, RS_TAB(shm), 0}; run_gemm_rs(WV, shm, hb2, wb + O_GU, 5632, 1024, E, ss1); } PH_END
        GSYNC;
        }
        PH_BEGIN { EpiRes E{hb2, hb, ss2}; run_gemm(WV, shm, actb, wb + O_DN, 1024, DFF, E); } PH_END
        if (L < 3) { PH_BEGIN unsigned* head = (unsigned*)(p.ws + WS_BAR) + 3840 + 16 * L; volatile unsigned* sq_ = (volatile unsigned*)(sm + 8192);
            for (;;) { __syncthreads(); if (tid == 0) sq_[0] = CONV_C1 + atomicAdd(head, 1u); __syncthreads(); const int q = (int)sq_[0]; if (q >= CONV_C2) break;
                conv_job(WV, p, L + 1, (bf16_t*)(p.ws + (((L + 1) & 1) ? WS_W1 : WS_W0)), q, sm); } PH_END }
        GSYNC;
        PH_BEGIN { EpiPG E{hb, hb2, ss3, pe, RS_TAB(shm), 0}; run_gemm_rs(WV, shm, hb, wb + O_PG, 1024, 1024, E, ss2); } PH_END
        if (L < 3) { PH_BEGIN unsigned* head = (unsigned*)(p.ws + WS_BAR) + 3840 + 16 * (4 + L); volatile unsigned* sq_ = (volatile unsigned*)(sm + 8192);
            for (;;) { __syncthreads(); if (tid == 0) sq_[0] = CONV_C2 + atomicAdd(head, 1u); __syncthreads(); const int q = (int)sq_[0]; if (q >= NCONV) break;
                conv_job(WV, p, L + 1, (bf16_t*)(p.ws + (((L + 1) & 1) ? WS_W1 : WS_W0)), q, sm); } PH_END }
        GSYNC;
    }
    { const int L = 0;
    PH_BEGIN const float* ssf = ss + (size_t)12 * MT * 16; const float* gf = p.in[32];
      for (int r0 = bid * 8 + wv; r0 < MT; r0 += 2 * nb * 8) { uint2 hv[2][4]; float rs2[2];
#pragma unroll
          for (int u_ = 0; u_ < 2; ++u_) { const int r = r0 + u_ * nb * 8; if (r < MT) { rs2[u_] = row_rstd(ssf, r);
#pragma unroll
              for (int j = 0; j < 4; ++j) hv[u_][j] = *(const uint2*)(hb + (size_t)r * 1024 + j * 256 + lane * 4); } }
#pragma unroll
          for (int u_ = 0; u_ < 2; ++u_) { const int r = r0 + u_ * nb * 8; if (r < MT) {
#pragma unroll
              for (int j = 0; j < 4; ++j) { float f[4]; unpack4(hv[u_][j], f); const f32x4 gg = *(const f32x4*)(gf + j * 256 + lane * 4);
                  *(f32x4*)(h + (size_t)r * 1024 + j * 256 + lane * 4) = (f32x4){f[0], f[1], f[2], f[3]} * rs2[u_] * gg; } } } }
    PH_END }
}

extern "C" void kernel_launch(void* const* d_in, const int* in_sizes, int n_in, void* d_out, int out_size, void* d_ws, size_t ws_size, hipStream_t stream) {
    constexpr size_t kDynLds = 131072 + 8192 + 16;
    static int grid_blocks = 0;
    if (!grid_blocks) {
        if (n_in != 33 || ws_size < WS_END) { fprintf(stderr, "kernel_launch: bad n_in %d or ws_size %zu < %zu\n", n_in, ws_size, (size_t)WS_END); grid_blocks = -1; return; }
        int dev = 0, cus = 0, per_cu = 0;
        hipGetDevice(&dev); hipDeviceGetAttribute(&cus, hipDeviceAttributeMultiprocessorCount, dev);
        hipFuncSetAttribute((const void*)mega, hipFuncAttributeMaxDynamicSharedMemorySize, (int)kDynLds);
        hipOccupancyMaxActiveBlocksPerMultiprocessor(&per_cu, (const void*)mega, 512, kDynLds);
        if (per_cu < 1) per_cu = 1;
        grid_blocks = cus * per_cu; if (grid_blocks > 256) grid_blocks = 256;
    }
    if (grid_blocks < 0) return;
    KP p{};
    for (int i = 0; i < 33; ++i) p.in[i] = (const float*)d_in[i];
    p.out = (float*)d_out; p.ws = (unsigned char*)d_ws;
    void* args[] = {&p};
    hipError_t e = hipLaunchCooperativeKernel((void*)mega, dim3(grid_blocks), dim3(512), args, kDynLds, stream);
    if (e != hipSuccess) fprintf(stderr, "cooperative launch failed: %s (grid %d)\n", hipGetErrorString(e), grid_blocks);
}
```
